# Optimizing an MI355X kernel written in HIP

```python
import math
import jax, jax.numpy as jnp
from jax import lax
import numpy as np

D_MODEL = 1024
BATCH = 8
SEQ = 8192
DEPTH = 2

RET_HEADS = 4
RET_QK_DIM = D_MODEL // RET_HEADS
RET_V_DIM = 2 * RET_QK_DIM
RET_QK_TOTAL = RET_HEADS * RET_QK_DIM
RET_V_TOTAL = RET_HEADS * RET_V_DIM
RET_IN_COLS = 2 * RET_QK_TOTAL + 2 * RET_V_TOTAL
RET_CHUNK = 128
ROPE_BASE = 10000.0
CONV_WIDTH = 3
D_FF = 7 * D_MODEL // 2
N_EXPERTS = 8
TOP_K = 2
NORM_EPS = 1e-6

kernel_name = "hybrid_retention_shortconv_moe"


def _rmsnorm(x, g):
    xf = x.astype(jnp.float32)
    y = xf * lax.rsqrt(jnp.mean(xf * xf, axis=-1, keepdims=True) + NORM_EPS)
    return (y * g.astype(jnp.float32)).astype(x.dtype)


def _rotary(t, pos):
    d = t.shape[-1]
    inv_freq = ROPE_BASE ** (-jnp.arange(0, d, 2, dtype=jnp.float32) / d)
    ang = pos[:, None] * inv_freq[None, :]
    cos = jnp.cos(ang)[None, :, None, :]
    sin = jnp.sin(ang)[None, :, None, :]
    t1, t2 = t[..., : d // 2], t[..., d // 2:]
    return jnp.concatenate([t1 * cos - t2 * sin, t1 * sin + t2 * cos], axis=-1)


def _retention(xn, w_in, w_out):
    b, s, _ = xn.shape
    proj = (xn @ w_in).astype(jnp.float32)
    q = proj[..., :RET_QK_TOTAL].reshape(b, s, RET_HEADS, RET_QK_DIM)
    k = proj[..., RET_QK_TOTAL:2 * RET_QK_TOTAL].reshape(b, s, RET_HEADS, RET_QK_DIM)
    v = proj[..., 2 * RET_QK_TOTAL:2 * RET_QK_TOTAL + RET_V_TOTAL].reshape(b, s, RET_HEADS, RET_V_DIM)
    g = proj[..., 2 * RET_QK_TOTAL + RET_V_TOTAL:]
    pos = jnp.arange(s, dtype=jnp.float32)
    q = _rotary(q, pos)
    k = _rotary(k, pos) * (RET_QK_DIM ** -0.5)

    nc = s // RET_CHUNK

    def to_chunks(t):
        return t.reshape(b, nc, RET_CHUNK, RET_HEADS, t.shape[-1]).transpose(1, 0, 3, 2, 4)

    qc, kc, vc = to_chunks(q), to_chunks(k), to_chunks(v)

    log_gamma = jnp.log(1.0 - 2.0 ** (-5.0 - jnp.arange(RET_HEADS, dtype=jnp.float32)))
    idx = jnp.arange(RET_CHUNK, dtype=jnp.float32)
    diff = idx[:, None] - idx[None, :]
    causal = diff >= 0
    intra_decay = jnp.where(causal[None], jnp.exp(jnp.where(causal, diff, 0.0)[None] * log_gamma[:, None, None]), 0.0)
    q_decay = jnp.exp((idx[None, :] + 1.0) * log_gamma[:, None])
    k_decay = jnp.exp((RET_CHUNK - 1.0 - idx[None, :]) * log_gamma[:, None])
    chunk_decay = jnp.exp(RET_CHUNK * log_gamma)

    def step(state, inp):
        q_i, k_i, v_i = inp
        scores = jnp.einsum('bhid,bhjd->bhij', q_i, k_i) * intra_decay[None]
        inner = jnp.einsum('bhij,bhje->bhie', scores, v_i)
        cross = jnp.einsum('bhid,bhde->bhie', q_i * q_decay[None, :, :, None], state)
        new_state = state * chunk_decay[None, :, None, None] + jnp.einsum(
            'bhjd,bhje->bhde', k_i * k_decay[None, :, :, None], v_i)
        return new_state, inner + cross

    state0 = jnp.zeros((b, RET_HEADS, RET_QK_DIM, RET_V_DIM), jnp.float32)
    _, o = lax.scan(step, state0, (qc, kc, vc))
    o = o.transpose(1, 0, 3, 2, 4).reshape(b, s, RET_HEADS, RET_V_DIM)
    o = o * lax.rsqrt(jnp.mean(o * o, axis=-1, keepdims=True) + NORM_EPS)
    o = jax.nn.silu(g) * o.reshape(b, s, RET_V_TOTAL)
    return o.astype(xn.dtype) @ w_out


def _short_conv(xn, w_in, w_conv, w_out):
    s = xn.shape[1]
    proj = xn @ w_in
    gate_b = proj[..., :D_MODEL]
    gate_c = proj[..., D_MODEL:2 * D_MODEL]
    h = proj[..., 2 * D_MODEL:]
    u = (gate_c * h).astype(jnp.float32)
    u_pad = jnp.pad(u, ((0, 0), (CONV_WIDTH - 1, 0), (0, 0)))
    wc = w_conv.astype(jnp.float32)
    y = sum(wc[j][None, None, :] * u_pad[:, j:j + s, :] for j in range(CONV_WIDTH))
    y = gate_b.astype(jnp.float32) * y
    return y.astype(xn.dtype) @ w_out


def _swiglu(xn, w_gate, w_up, w_down):
    return (jax.nn.silu(xn @ w_gate) * (xn @ w_up)) @ w_down


def _moe_swiglu(xn, w_router, w_gate_e, w_up_e, w_down_e):
    b, s, d = xn.shape
    t = xn.reshape(b * s, d)
    logits = (t @ w_router).astype(jnp.float32)
    top_vals, top_idx = lax.top_k(logits, TOP_K)
    top_w = jax.nn.softmax(top_vals, axis=-1)
    gates = jnp.sum(jax.nn.one_hot(top_idx, N_EXPERTS, dtype=jnp.float32) * top_w[..., None], axis=1)
    out = jnp.zeros((b * s, d), jnp.float32)
    for e in range(N_EXPERTS):
        h = jax.nn.silu(t @ w_gate_e[e]) * (t @ w_up_e[e])
        out = out + gates[:, e:e + 1] * (h @ w_down_e[e]).astype(jnp.float32)
    return out.astype(xn.dtype).reshape(b, s, d)


def setup_inputs(seed: int = 0) -> dict:
    key = jax.random.key(seed)
    ks = jax.random.split(key, 24)

    def w(k, shape, fan_in):
        return jax.random.normal(k, shape, jnp.float32) * (fan_in ** -0.5)

    def gain(k):
        return 1.0 + 0.02 * jax.random.normal(k, (D_MODEL,), jnp.float32)

    return {
        "x": jax.random.normal(ks[0], (BATCH, SEQ, D_MODEL), jnp.float32),
        "norm_mix0": gain(ks[1]),
        "ret_w_in": w(ks[2], (D_MODEL, RET_IN_COLS), D_MODEL),
        "ret_w_out": w(ks[3], (RET_V_TOTAL, D_MODEL), RET_V_TOTAL),
        "norm_ffn0": gain(ks[4]),
        "ffn_w_gate": w(ks[5], (D_MODEL, D_FF), D_MODEL),
        "ffn_w_up": w(ks[6], (D_MODEL, D_FF), D_MODEL),
        "ffn_w_down": w(ks[7], (D_FF, D_MODEL), D_FF),
        "norm_mix1": gain(ks[8]),
        "conv_w_in": w(ks[9], (D_MODEL, 3 * D_MODEL), D_MODEL),
        "conv_w": w(ks[10], (CONV_WIDTH, D_MODEL), CONV_WIDTH),
        "conv_w_out": w(ks[11], (D_MODEL, D_MODEL), D_MODEL),
        "norm_ffn1": gain(ks[12]),
        "moe_router": w(ks[13], (D_MODEL, N_EXPERTS), D_MODEL),
        "moe_w_gate": w(ks[14], (N_EXPERTS, D_MODEL, D_FF), D_MODEL),
        "moe_w_up": w(ks[15], (N_EXPERTS, D_MODEL, D_FF), D_MODEL),
        "moe_w_down": w(ks[16], (N_EXPERTS, D_FF, D_MODEL), D_FF),
        "norm_final": gain(ks[17]),
    }


def reference(x, norm_mix0, ret_w_in, ret_w_out, norm_ffn0, ffn_w_gate, ffn_w_up, ffn_w_down,
              norm_mix1, conv_w_in, conv_w, conv_w_out, norm_ffn1, moe_router, moe_w_gate,
              moe_w_up, moe_w_down, norm_final):
    mixer_params = [(norm_mix0, ret_w_in, ret_w_out), (norm_mix1, conv_w_in, conv_w, conv_w_out)]
    ffn_params = [(norm_ffn0, ffn_w_gate, ffn_w_up, ffn_w_down),
                  (norm_ffn1, moe_router, moe_w_gate, moe_w_up, moe_w_down)]
    h = x
    for i in range(DEPTH):
        mp = mixer_params[i]
        if i % 2 == 0:
            h = h + _retention(_rmsnorm(h, mp[0]), mp[1], mp[2])
        else:
            h = h + _short_conv(_rmsnorm(h, mp[0]), mp[1], mp[2], mp[3])
        fp = ffn_params[i]
        if i % 2 == 0:
            h = h + _swiglu(_rmsnorm(h, fp[0]), fp[1], fp[2], fp[3])
        else:
            h = h + _moe_swiglu(_rmsnorm(h, fp[0]), fp[1], fp[2], fp[3], fp[4])
    return _rmsnorm(h, norm_final)
```

```cpp
#include <hip/hip_runtime.h>
#include <cstdio>
#include <cstdint>

#ifndef MK_BAL
#define MK_BAL 1
#endif
namespace pg8 {
#define PG8_LAS __attribute__((address_space(3)))
typedef unsigned short bf16_t;
typedef short bf16x8 __attribute__((ext_vector_type(8)));
typedef float f32x4 __attribute__((ext_vector_type(4)));
typedef float f32x2 __attribute__((ext_vector_type(2)));
typedef unsigned u32x4 __attribute__((ext_vector_type(4)));
typedef unsigned u32x2 __attribute__((ext_vector_type(2)));
constexpr int BM = 256, BK = 64, HALF = 128, HTB = HALF * BK * 2, STAGE_BYTES = 8 * HTB, NXCD = 8, WGM = 8;

__host__ __device__ __forceinline__ int lds_byte(int r, int c) { const int st = (r >> 4) * 2 + (c >> 5), rr = r & 15, cc = c & 31, ob = rr * 64 + cc * 2; return st * 1024 + (ob ^ (((ob >> 9) & 1) << 5)); }
__host__ __device__ __forceinline__ void stage_rc(int b, int& R, int& C) { const int st = b / 1024, sb = b % 1024, swz = sb ^ (((sb >> 9) & 1) << 5); R = (st >> 1) * 16 + swz / 64; C = (st & 1) * 32 + (swz % 64) / 2; }
__host__ __device__ __forceinline__ int lds_byteB(int r, int cb) { const int st = (r >> 4) * 2 + (cb >> 6), ob0 = (r & 15) * 64 + (cb & 63); return st * 1024 + (ob0 ^ (((ob0 >> 9) & 1) << 5)); }
typedef int v8i __attribute__((ext_vector_type(8)));
typedef int v4i __attribute__((ext_vector_type(4)));
__host__ __device__ __forceinline__ int perm32(int rho) { const int n = rho >> 4, i = rho & 15; return 8 * (i >> 2) + 4 * n + (i & 3); }

struct Unit { int pm, pn, pmo, pno; };
struct Gemm { const bf16_t* A; const bf16_t* Bt; int K; const int* gidx; const unsigned long long* hss; bool aimg = false; };

struct StaticOrder {
    int nM, nN, nwg, G, c;
    __host__ __device__ void init(int nM_, int nN_, int G_, int c_) { nM = nM_; nN = nN_; nwg = nM * nN; G = G_; c = c_; }
    __host__ __device__ bool next(int i, Unit& u) const {
        const long L = (long)i * G + c; if (L >= nwg) return false;
        int wgid = (int)L; { const int q = nwg / NXCD, r = nwg % NXCD, xcd = wgid % NXCD, off = wgid / NXCD; wgid = (xcd < r ? xcd * (q + 1) : r * (q + 1) + (xcd - r) * q) + off; }
        const int nig = WGM * nN, gid = wgid / nig, fm = gid * WGM, gsz = (nM - fm) < WGM ? (nM - fm) : WGM;
        u.pm = fm + ((wgid % nig) % gsz); u.pn = (wgid % nig) / gsz; u.pmo = u.pm; u.pno = u.pn; return true;
    }
};
struct MoeOrder {
    StaticOrder base; int t0, ntile_e; int o1, o2, o3, o4, o5, o6, o7; bool a_local;
    __device__ bool next(int i, Unit& u) const {
        if (!base.next(i, u)) return false;
        const int l = u.pm, t = t0 + l;
        const int e = (t >= o1) + (t >= o2) + (t >= o3) + (t >= o4) + (t >= o5) + (t >= o6) + (t >= o7);
        u.pno = u.pn; u.pn = e * ntile_e + u.pn;
        if (a_local) { u.pm = l; u.pmo = t; } else { u.pm = t; u.pmo = l; }
        return true;
    }
};

__device__ __forceinline__ int opq_i(int v) { asm volatile("" : "+v"(v)); return v; }
__device__ __forceinline__ unsigned cvt_pk_bf16(float lo, float hi) { unsigned r; asm volatile("v_cvt_pk_bf16_f32 %0, %1, %2" : "=v"(r) : "v"(lo), "v"(hi)); return r; }
__device__ __forceinline__ unsigned pk4_fp8(float a, float b, float c, float d) { int w = 0; w = __builtin_amdgcn_cvt_pk_fp8_f32(a, b, w, false); w = __builtin_amdgcn_cvt_pk_fp8_f32(c, d, w, true); return (unsigned)w; }
__device__ __forceinline__ float silu_f(float v) { return v * __builtin_amdgcn_rcpf(1.0f + __expf(-v)); }
__device__ __forceinline__ u32x4 widen16(u32x2 X, u32x2 Y) {
    const auto r0 = __builtin_amdgcn_permlane16_swap(X.x, Y.x, false, false); const auto r1 = __builtin_amdgcn_permlane16_swap(X.y, Y.y, false, false);
    return (u32x4){r0[0], r1[0], r0[1], r1[1]};
}
__device__ __forceinline__ void swiglu8(const f32x4 g0, const f32x4 g1, const f32x4 u0, const f32x4 u1, float rs, float post, f32x4& h0, f32x4& h1) {
    const float nl = rs * -1.44269504f, k = __builtin_amdgcn_rcpf(rs * rs * post);
    f32x4 e0 = g0 * nl, e1 = g1 * nl;
#pragma unroll
    for (int x = 0; x < 4; ++x) { e0[x] = __builtin_amdgcn_exp2f(e0[x]); e1[x] = __builtin_amdgcn_exp2f(e1[x]); }
    f32x4 d0 = e0 * k + k, d1 = e1 * k + k;
#pragma unroll
    for (int x = 0; x < 4; ++x) { d0[x] = __builtin_amdgcn_rcpf(d0[x]); d1[x] = __builtin_amdgcn_rcpf(d1[x]); }
    h0 = g0 * u0 * d0; h1 = g1 * u1 * d1;
}

struct EpiSwiglu {
    static constexpr bool PERM = true;
    bf16_t* O; int ldc; const unsigned long long* ssq; const float* rsd;
    int last_pm; float rsc[2][4];
    unsigned char* O8; float post8;
    __device__ __forceinline__ void operator()(const f32x4 (&acc)[2][2][4][2], const Unit& u, int wr, int wc, int fr, int fq) {
        const int row0 = u.pmo * BM + wr * 64 + fr; const int col0 = u.pno * HALF + wc * 32 + 8 * fq; const int rsr0 = u.pm * BM + wr * 64 + fr;
        if (u.pm != last_pm) { last_pm = u.pm;
#pragma unroll
            for (int ai = 0; ai < 2; ++ai)
#pragma unroll
                for (int m = 0; m < 4; ++m) rsc[ai][m] = ssq ? __builtin_amdgcn_rsqf((float)ssq[rsr0 + ai * HALF + m * 16] * (1.0f / (1024.0f * 4294967296.0f)) + 1e-6f) : rsd[rsr0 + ai * HALF + m * 16]; }
        if (O8) {
#pragma unroll
            for (int ai = 0; ai < 2; ++ai)
#pragma unroll
                for (int mp = 0; mp < 2; ++mp) { u32x2 w8[2];
#pragma unroll
                    for (int j = 0; j < 2; ++j) { const int m = 2 * mp + j; f32x4 h0, h1; swiglu8(acc[ai][0][m][0], acc[ai][0][m][1], acc[ai][1][m][0], acc[ai][1][m][1], rsc[ai][m], post8, h0, h1);
                        w8[j].x = pk4_fp8(h0[0], h0[1], h0[2], h0[3]); w8[j].y = pk4_fp8(h1[0], h1[1], h1[2], h1[3]); }
                    const int r = row0 + ai * HALF + (2 * mp + (fq & 1)) * 16;
                    *(u32x4*)(O8 + ((size_t)(r >> 7) * (ldc / HALF) + u.pno) * HTB + (((r & 127) >> 4) * 2 + (wc >> 1)) * 1024 + (((fr * 64 + 32 * (wc & 1) + 8 * (fq & 2))) ^ ((fr >> 3) << 5))) = widen16(w8[0], w8[1]); }
        } else {
#pragma unroll
        for (int ai = 0; ai < 2; ++ai)
#pragma unroll
            for (int m = 0; m < 4; ++m) { const int r = row0 + ai * HALF + m * 16; bf16_t* rowp = O + (size_t)r * ldc + col0;
                const float rs = rsc[ai][m];
                f32x4 h0, h1; swiglu8(acc[ai][0][m][0], acc[ai][0][m][1], acc[ai][1][m][0], acc[ai][1][m][1], rs, 1.0f, h0, h1);
                u32x4 w; w.x = cvt_pk_bf16(h0[0], h0[1]); w.y = cvt_pk_bf16(h0[2], h0[3]); w.z = cvt_pk_bf16(h1[0], h1[1]); w.w = cvt_pk_bf16(h1[2], h1[3]);
                *(u32x4*)rowp = w; } }
    }
};
struct EpiConvIn {
    static constexpr bool PERM = true;
    bf16_t* Bc; bf16_t* U; const unsigned long long* ssq;
    int last_pm; float rsc[2][4];
    __device__ __forceinline__ void operator()(const f32x4 (&acc)[2][2][4][2], const Unit& u, int wr, int wc, int fr, int fq) {
        const int row0 = u.pmo * BM + wr * 64 + fr;
        if (u.pmo != last_pm) { last_pm = u.pmo;
#pragma unroll
            for (int ai = 0; ai < 2; ++ai)
#pragma unroll
                for (int m = 0; m < 4; ++m) rsc[ai][m] = __builtin_amdgcn_rsqf((float)ssq[row0 + ai * HALF + m * 16] * (1.0f / (1024.0f * 4294967296.0f)) + 1e-6f); }
        if (u.pno < 4) {
            const int col0 = u.pno * BM + wc * 32 + 8 * fq;
#pragma unroll
            for (int ai = 0; ai < 2; ++ai)
#pragma unroll
                for (int m = 0; m < 4; ++m) { bf16_t* rowp = Bc + (size_t)(row0 + ai * HALF + m * 16) * 1024 + col0; const float rs = rsc[ai][m];
#pragma unroll
                    for (int bj = 0; bj < 2; ++bj) { const f32x4 v0 = acc[ai][bj][m][0] * rs, v1 = acc[ai][bj][m][1] * rs;
                        u32x4 w; w.x = cvt_pk_bf16(v0[0], v0[1]); w.y = cvt_pk_bf16(v0[2], v0[3]); w.z = cvt_pk_bf16(v1[0], v1[1]); w.w = cvt_pk_bf16(v1[2], v1[3]);
                        *(u32x4*)(rowp + bj * HALF) = w; } }
        } else {
            const int col0 = (u.pno - 4) * HALF + wc * 32 + 8 * fq;
#pragma unroll
            for (int ai = 0; ai < 2; ++ai)
#pragma unroll
                for (int m = 0; m < 4; ++m) { bf16_t* rowp = U + (size_t)(row0 + ai * HALF + m * 16) * 1024 + col0; const float rs2 = rsc[ai][m] * rsc[ai][m];
                    const f32x4 v0 = acc[ai][0][m][0] * acc[ai][1][m][0] * rs2, v1 = acc[ai][0][m][1] * acc[ai][1][m][1] * rs2;
                    u32x4 w; w.x = cvt_pk_bf16(v0[0], v0[1]); w.y = cvt_pk_bf16(v0[2], v0[3]); w.z = cvt_pk_bf16(v1[0], v1[1]); w.w = cvt_pk_bf16(v1[2], v1[3]);
                    *(u32x4*)rowp = w; }
        }
    }
};
struct EpiSwiglu8 {
    static constexpr bool PERM = true;
    unsigned char* O; int ldc; const float* rsd; float pre, post;
    int last_pm; float rsc[2][4];
    __device__ __forceinline__ void operator()(const f32x4 (&acc)[2][2][4][2], const Unit& u, int wr, int wc, int fr_, int fq_) {
        const int fr = opq_i(fr_), fq = opq_i(fq_);
        const int row0 = u.pmo * BM + wr * 64 + fr; const int col0 = u.pno * HALF + wc * 32 + 8 * fq; const int rsr0 = u.pm * BM + wr * 64 + fr;
        if (u.pm != last_pm) { last_pm = u.pm;
#pragma unroll
            for (int ai = 0; ai < 2; ++ai)
#pragma unroll
                for (int m = 0; m < 4; ++m) rsc[ai][m] = rsd[rsr0 + ai * HALF + m * 16] * pre; }
#pragma unroll
        for (int ai = 0; ai < 2; ++ai)
#pragma unroll
            for (int mp = 0; mp < 2; ++mp) { u32x2 w8[2];
#pragma unroll
                for (int j = 0; j < 2; ++j) { const int m = 2 * mp + j; f32x4 h0, h1; swiglu8(acc[ai][0][m][0], acc[ai][0][m][1], acc[ai][1][m][0], acc[ai][1][m][1], rsc[ai][m], post, h0, h1);
                    w8[j].x = pk4_fp8(h0[0], h0[1], h0[2], h0[3]); w8[j].y = pk4_fp8(h1[0], h1[1], h1[2], h1[3]); }
                const int r = row0 + ai * HALF + (2 * mp + (fq & 1)) * 16;
                *(u32x4*)(O + ((size_t)(r >> 7) * (ldc / HALF) + u.pno) * HTB + (((r & 127) >> 4) * 2 + (wc >> 1)) * 1024 + (((fr * 64 + 32 * (wc & 1) + 8 * (fq & 2))) ^ ((fr >> 3) << 5))) = widen16(w8[0], w8[1]); }
    }
};
struct EpiScaleF8 {
    static constexpr bool PERM = true;
    unsigned char* O; int ldc; float sc;
    __device__ __forceinline__ void operator()(const f32x4 (&acc)[2][2][4][2], const Unit& u, int wr, int wc, int fr_, int fq_) const {
        const int fr = opq_i(fr_), fq = opq_i(fq_);
        const int row0 = u.pmo * BM + wr * 64 + fr; const int col0 = u.pno * BM + wc * 32 + 8 * fq;
#pragma unroll
        for (int ai = 0; ai < 2; ++ai)
#pragma unroll
            for (int mp = 0; mp < 2; ++mp) { unsigned char* rowp = O + (size_t)(row0 + ai * HALF + (2 * mp + (fq & 1)) * 16) * ldc + col0 - 8 * (fq & 1);
#pragma unroll
                for (int bj = 0; bj < 2; ++bj) { u32x2 w8[2];
#pragma unroll
                    for (int j = 0; j < 2; ++j) { const f32x4 v0 = acc[ai][bj][2 * mp + j][0] * sc, v1 = acc[ai][bj][2 * mp + j][1] * sc;
                        w8[j].x = pk4_fp8(v0[0], v0[1], v0[2], v0[3]); w8[j].y = pk4_fp8(v1[0], v1[1], v1[2], v1[3]); }
                    *(u32x4*)(rowp + bj * HALF) = widen16(w8[0], w8[1]); } }
    }
};
struct EpiProbe {
    static constexpr bool PERM = true;
    bf16_t* O;
    __device__ __forceinline__ void operator()(const f32x4 (&acc)[2][2][4][2], const Unit& u, int wr, int wc, int fr, int fq) const {
        f32x4 s = (f32x4){0.f, 0.f, 0.f, 0.f};
#pragma unroll
        for (int ai = 0; ai < 2; ++ai)
#pragma unroll
            for (int m = 0; m < 4; ++m)
#pragma unroll
                for (int bj = 0; bj < 2; ++bj) s += acc[ai][bj][m][0] + acc[ai][bj][m][1];
        if (s[0] + s[1] + s[2] + s[3] == 1.2345e33f) O[u.pmo] = 1;
    }
};
template <bool BASE_BF16, bool OUT_F32> struct EpiResNorm {
    static constexpr bool PERM = true;
    const float* base_f; const bf16_t* base_b; float* out; bf16_t* hb; unsigned long long* ssq; int ldc; float accs;
    __device__ __forceinline__ void operator()(const f32x4 (&acc)[2][2][4][2], const Unit& u, int wr, int wc, int fr, int fq) const {
        const int row0 = u.pmo * BM + wr * 64 + fr, col0 = u.pno * BM + wc * 32 + 8 * fq;
#pragma unroll
        for (int ai = 0; ai < 2; ++ai) {
            f32x4 bf[4][2][2]; u32x4 bw[4][2];
#pragma unroll
            for (int m = 0; m < 4; ++m)
#pragma unroll
                for (int bj = 0; bj < 2; ++bj) { const size_t off = (size_t)(row0 + ai * HALF + m * 16) * ldc + col0 + bj * HALF;
                    if constexpr (BASE_BF16) bw[m][bj] = *(const u32x4*)(base_b + off);
                    else { bf[m][bj][0] = *(const f32x4*)(base_f + off); bf[m][bj][1] = *(const f32x4*)(base_f + off + 4); } }
            __builtin_amdgcn_sched_barrier(0);
            float ss[4];
#pragma unroll
            for (int m = 0; m < 4; ++m) { const size_t off = (size_t)(row0 + ai * HALF + m * 16) * ldc + col0; ss[m] = 0.f;
#pragma unroll
                for (int bj = 0; bj < 2; ++bj) { f32x4 b0, b1;
                    if constexpr (BASE_BF16) { const u32x4 w_ = bw[m][bj];
                        b0 = (f32x4){__builtin_bit_cast(float, w_.x << 16), __builtin_bit_cast(float, w_.x & 0xffff0000u), __builtin_bit_cast(float, w_.y << 16), __builtin_bit_cast(float, w_.y & 0xffff0000u)};
                        b1 = (f32x4){__builtin_bit_cast(float, w_.z << 16), __builtin_bit_cast(float, w_.z & 0xffff0000u), __builtin_bit_cast(float, w_.w << 16), __builtin_bit_cast(float, w_.w & 0xffff0000u)}; }
                    else { b0 = bf[m][bj][0]; b1 = bf[m][bj][1]; }
                    const f32x4 v0 = b0 + acc[ai][bj][m][0] * accs, v1 = b1 + acc[ai][bj][m][1] * accs;
                    if constexpr (OUT_F32) { *(f32x4*)(out + off + bj * HALF) = v0; *(f32x4*)(out + off + bj * HALF + 4) = v1; }
                    if (hb) { u32x4 w; w.x = cvt_pk_bf16(v0[0], v0[1]); w.y = cvt_pk_bf16(v0[2], v0[3]); w.z = cvt_pk_bf16(v1[0], v1[1]); w.w = cvt_pk_bf16(v1[2], v1[3]);
                        *(u32x4*)(hb + off + bj * HALF) = w; }
                    ss[m] += (v0[0] * v0[0] + v0[1] * v0[1]) + (v0[2] * v0[2] + v0[3] * v0[3]) + (v1[0] * v1[0] + v1[1] * v1[1]) + (v1[2] * v1[2] + v1[3] * v1[3]); } }
            if (ssq) {
#pragma unroll
                for (int m = 0; m < 4; ++m) { ss[m] += __shfl_xor(ss[m], 16); ss[m] += __shfl_xor(ss[m], 32); }
                if (fq == 0) {
#pragma unroll
                    for (int m = 0; m < 4; ++m) __hip_atomic_fetch_add(ssq + row0 + ai * HALF + m * 16, (unsigned long long)(ss[m] * 4294967296.0f), __ATOMIC_RELAXED, __HIP_MEMORY_SCOPE_AGENT); } }
            asm volatile("" ::: "memory"); }
    }
};
struct EpiRetIn {
    static constexpr bool PERM = true;
    bf16_t *Q, *Kk, *V, *G; const float* invf;
    __device__ __forceinline__ void operator()(const f32x4 (&acc)[2][2][4][2], const Unit& u, int wr, int wc, int fr, int fq) const {
        const int row0 = u.pmo * BM + wr * 64 + fr, pn = u.pno;
        if (pn < 8) {
            const int h = pn & 3;
            const int lb = (fr * 64 + fq * 16) ^ ((fr >> 3) << 5);
            unsigned char* kdst = (unsigned char*)Kk + (size_t)(4 * h + (wc >> 1)) * HTB + (wc & 1) * 1024 + lb;
            bf16_t* qdst = Q + (size_t)h * 4096 + wc * 512 + (fq * 16 + fr) * 8;
            const float l2g = __log2f(1.0f - exp2f(-(float)(5 + h)));
            const float l2s = pn < 4 ? l2g : -l2g, scm = pn < 4 ? 1.0f : 0.0625f;
            const size_t d2 = pn < 4 ? (size_t)4096 : (size_t)(2 * HTB);
            const float* tbl = invf + (size_t)(wc * 4 * 64 + fq * 16 + fr) * 4;
            f32x4 tq[2][4];
#pragma unroll
            for (int q = 0; q < 4; ++q) tq[0][q] = *(const f32x4*)(tbl + (size_t)((row0 & 8191) >> 4) * 4096 + q * 256);
#pragma unroll
            for (int ai = 0; ai < 2; ++ai)
#pragma unroll
                for (int m = 0; m < 4; ++m) { const int r = row0 + ai * HALF + m * 16, ic = r & 127; constexpr int unused_ = 0; (void)unused_;
                    const int gi = ai * 4 + m;
                    if (gi < 7) { const int rn = row0 + ((gi + 1) >> 2) * HALF + ((gi + 1) & 3) * 16;
#pragma unroll
                        for (int q = 0; q < 4; ++q) tq[(gi + 1) & 1][q] = *(const f32x4*)(tbl + (size_t)((rn & 8191) >> 4) * 4096 + q * 256); }
                    const float sc = __builtin_amdgcn_exp2f((float)ic * l2s) * scm;
                    float cs[8], sn[8];
#pragma unroll
                    for (int j = 0; j < 4; ++j) { cs[j] = tq[gi & 1][0][j] * sc; cs[4 + j] = tq[gi & 1][1][j] * sc; sn[j] = tq[gi & 1][2][j] * sc; sn[4 + j] = tq[gi & 1][3][j] * sc; }
                    const f32x4 a0 = acc[ai][0][m][0], a1 = acc[ai][0][m][1], b0 = acc[ai][1][m][0], b1 = acc[ai][1][m][1];
                    f32x4 o10, o11, o20, o21;
#pragma unroll
                    for (int x = 0; x < 4; ++x) { o10[x] = a0[x] * cs[x] - b0[x] * sn[x]; o20[x] = a0[x] * sn[x] + b0[x] * cs[x];
                        o11[x] = a1[x] * cs[4 + x] - b1[x] * sn[4 + x]; o21[x] = a1[x] * sn[4 + x] + b1[x] * cs[4 + x]; }
                    u32x4 w1, w2; w1.x = cvt_pk_bf16(o10[0], o10[1]); w1.y = cvt_pk_bf16(o10[2], o10[3]); w1.z = cvt_pk_bf16(o11[0], o11[1]); w1.w = cvt_pk_bf16(o11[2], o11[3]);
                    w2.x = cvt_pk_bf16(o20[0], o20[1]); w2.y = cvt_pk_bf16(o20[2], o20[3]); w2.z = cvt_pk_bf16(o21[0], o21[1]); w2.w = cvt_pk_bf16(o21[2], o21[3]);
                    unsigned char* bp = pn < 4 ? (unsigned char*)(qdst + (size_t)(r >> 4) * 16384) : kdst + (size_t)(r >> 7) * (16 * HTB) + ((r & 127) >> 4) * 2048;
                    *(u32x4*)bp = w1; *(u32x4*)(bp + d2) = w2; }
        } else {
            const int lb = (fr * 64 + fq * 16) ^ ((fr >> 3) << 5);
            unsigned char* dst = (unsigned char*)(pn < 16 ? V : G) + (size_t)(((pn & 7) * 4) + (wc >> 1)) * HTB + (wc & 1) * 1024 + lb;
#pragma unroll
            for (int ai = 0; ai < 2; ++ai)
#pragma unroll
                for (int m = 0; m < 4; ++m) { const int r = row0 + ai * HALF + m * 16; unsigned char* rowp = dst + (size_t)(r >> 7) * (32 * HTB) + ((r & 127) >> 4) * 2048;
#pragma unroll
                    for (int bj = 0; bj < 2; ++bj) { const f32x4 v0 = acc[ai][bj][m][0], v1 = acc[ai][bj][m][1];
                        u32x4 w; w.x = cvt_pk_bf16(v0[0], v0[1]); w.y = cvt_pk_bf16(v0[2], v0[3]); w.z = cvt_pk_bf16(v1[0], v1[1]); w.w = cvt_pk_bf16(v1[2], v1[3]);
                        *(u32x4*)(rowp + bj * 2 * HTB) = w; } }
        }
    }
};

__device__ __forceinline__ void a_offsets(const int* gidx, int pm, int rowb, const int (&R)[2], const int (&C)[2], unsigned (&o)[2][2], bool aimg = false, int tid16 = 0) {
    if (aimg) {
#pragma unroll
        for (int h = 0; h < 2; ++h)
#pragma unroll
            for (int i = 0; i < 2; ++i) o[h][i] = (unsigned)(2 * pm + h) * (unsigned)(rowb / (2 * BK)) * (unsigned)HTB + (unsigned)(tid16 + i * 8192);
        return; }
#pragma unroll
    for (int h = 0; h < 2; ++h)
#pragma unroll
        for (int i = 0; i < 2; ++i) { const int rl = pm * BM + h * HALF + R[i]; const int row = gidx ? gidx[rl] : rl; o[h][i] = (unsigned)row * (unsigned)rowb + (unsigned)C[i] * 2u; }
}

template <class Epi, class Sched, bool F8 = false, bool HS = false>
__device__ __forceinline__ void gemm_phase(PG8_LAS unsigned char* lds, const Gemm g, const Sched& S, Epi& E) {
    int tid_ = threadIdx.x; asm volatile("" : "+v"(tid_));
    const int tid = tid_, wid = __builtin_amdgcn_readfirstlane(tid >> 6), lane = tid & 63, wr = wid >> 2, wc = wid & 3, fr = lane & 15, fq = lane >> 4;
    const int K = g.K, rowb = F8 ? K : 2 * K, nt = rowb / (2 * BK);
    int Rr[2], Cc[2]; unsigned voffB[2];
#pragma unroll
    for (int i = 0; i < 2; ++i) { int R, C; stage_rc(tid * 16 + i * 8192, R, C); Rr[i] = R; Cc[i] = C; voffB[i] = (unsigned)(tid * 16 + i * 8192); }
    static_assert(Epi::PERM, "the pre-tiled weight images are written in perm32 row order");
    const size_t kstep = g.aimg ? (size_t)HTB : (size_t)(BK * 2);
    const size_t kstepB = (size_t)HTB;
    const size_t hstep = (size_t)nt * HTB;
    const size_t tstep = 2 * hstep;
    const unsigned ldsw = (unsigned)wid * 1024u;
    const int aoff = lds_byte(wr * 64 + fr, fq * 8), boff = lds_byte(wc * 32 + fr, fq * 8);
#define PG8_SA(b, h) (((b) * 2 + (h)) * HTB)
#define PG8_SB(b, h) ((4 + (b) * 2 + (h)) * HTB)
#define PG8_STAGE(bufoff, gbase, voff) do { _Pragma("unroll") for (int _i = 0; _i < 2; ++_i) \
        __builtin_amdgcn_global_load_lds((const unsigned*)((const char*)(gbase) + (voff)[_i]), (PG8_LAS unsigned*)(lds + (bufoff) + ldsw + _i * 8192), 16, 0, 0); } while (0)
#define PG8_LD8(p) __builtin_shufflevector(*(const PG8_LAS v4i*)(p), *(const PG8_LAS v4i*)((p) + 1024), 0, 1, 2, 3, 4, 5, 6, 7)
#define PG8_LDA(dst, b, h) do { if constexpr (F8) { _Pragma("unroll") for (int m = 0; m < 4; ++m) dst##8[m] = PG8_LD8(lds + PG8_SA(b, h) + aoff + m * 2048); } \
        else { _Pragma("unroll") for (int m = 0; m < 4; ++m) _Pragma("unroll") for (int k = 0; k < 2; ++k) dst[m][k] = *(const PG8_LAS bf16x8*)(lds + PG8_SA(b, h) + aoff + m * 2048 + k * 1024); } } while (0)
#define PG8_LDB(dst, b, h) do { if constexpr (F8) { _Pragma("unroll") for (int n = 0; n < 2; ++n) dst##8[n] = PG8_LD8(lds + PG8_SB(b, h) + boff + n * 2048); } \
        else { _Pragma("unroll") for (int n = 0; n < 2; ++n) _Pragma("unroll") for (int k = 0; k < 2; ++k) dst[n][k] = *(const PG8_LAS bf16x8*)(lds + PG8_SB(b, h) + boff + n * 2048 + k * 1024); } } while (0)
#define PG8_MMA(ai, bj, At, Bt) do { __builtin_amdgcn_s_setprio(1); _Pragma("unroll") for (int m = 0; m < 4; ++m) _Pragma("unroll") for (int n = 0; n < 2; ++n) { \
        if constexpr (F8) asm volatile("v_mfma_scale_f32_16x16x128_f8f6f4 %0, %1, %2, %0, %3, %3 op_sel_hi:[0,0,0]" : "+v"(acc[ai][bj][m][n]) : "v"(Bt##8[n]), "v"(At##8[m]), "v"(one8)); \
        else { _Pragma("unroll") for (int k = 0; k < 2; ++k) acc[ai][bj][m][n] = __builtin_amdgcn_mfma_f32_16x16x32_bf16(Bt[n][k], At[m][k], acc[ai][bj][m][n], 0, 0, 0); } } __builtin_amdgcn_s_setprio(0); } while (0)
#define PG8_WAIT_V(n) asm volatile("s_waitcnt vmcnt(" #n ")" ::: "memory")
#define PG8_WAIT_L(n) asm volatile("s_waitcnt lgkmcnt(" #n ")" ::: "memory")
#define PG8_BAR __builtin_amdgcn_s_barrier()
#define PG8_SCHED __builtin_amdgcn_sched_barrier(0)
    Unit cur, nxt; int ui = 0;
    if (!S.next(0, cur)) return;
    f32x4 acc[2][2][4][2];
#pragma unroll
    for (int a = 0; a < 2; ++a)
#pragma unroll
        for (int b = 0; b < 2; ++b)
#pragma unroll
            for (int m = 0; m < 4; ++m)
#pragma unroll
                for (int n = 0; n < 2; ++n) acc[a][b][m][n] = (f32x4){0.f, 0.f, 0.f, 0.f};
    bf16x8 At[4][2], B0[2][2], B1[2][2]; v8i At8[4], B08[2], B18[2];
    const int one8 = 0x7f7f7f7f;
    unsigned offC[2][2], offN[2][2];
    a_offsets(g.gidx, cur.pm, rowb, Rr, Cc, offC, g.aimg, tid * 16);
    const char* const Ab = (const char*)g.A;
    const char* cB = (const char*)g.Bt + (size_t)cur.pn * tstep;
    PG8_STAGE(PG8_SB(0, 0), cB, voffB); PG8_STAGE(PG8_SB(0, 1), cB + hstep, voffB); PG8_STAGE(PG8_SA(0, 0), Ab, offC[0]); PG8_STAGE(PG8_SA(0, 1), Ab, offC[1]);
    if (wr == 1) PG8_BAR;
    PG8_WAIT_V(2); PG8_BAR;
    constexpr bool BAL = (MK_BAL != 0) && !F8;
    if constexpr (BAL) { PG8_STAGE(PG8_SB(1, 0), cB + kstepB, voffB); PG8_STAGE(PG8_SA(1, 0), Ab + kstep, offC[0]); PG8_WAIT_V(4); PG8_BAR; }
    else { PG8_STAGE(PG8_SB(1, 0), cB + kstepB, voffB); PG8_STAGE(PG8_SA(1, 0), Ab + kstep, offC[0]); PG8_STAGE(PG8_SB(1, 1), cB + hstep + kstepB, voffB);
    PG8_WAIT_V(6); PG8_BAR; }
    for (;;) {
        const bool has_next = S.next(ui + 1, nxt);
        if (has_next && !(g.gidx && nxt.pm == cur.pm)) a_offsets(g.gidx, nxt.pm, rowb, Rr, Cc, offN, g.aimg, tid * 16);
        else {
#pragma unroll
            for (int h = 0; h < 2; ++h)
#pragma unroll
                for (int i = 0; i < 2; ++i) offN[h][i] = offC[h][i]; }
        const char* nB = has_next ? (const char*)g.Bt + (size_t)nxt.pn * tstep : cB;
        PG8_LAS float* const hstab = (PG8_LAS float*)(lds + STAGE_BYTES + 1024 + (ui & 1) * 4096);
        if constexpr (HS) { if (tid < 256) { const u32x4* p = (const u32x4*)(g.hss + (size_t)(cur.pm * BM + tid) * 4); const u32x4 lo = p[0], hi = p[1];
            const float k = 1.0f / (512.0f * 4294967296.0f);
            const float r0 = __builtin_amdgcn_rsqf((float)(((unsigned long long)lo.y << 32) | lo.x) * k + 1e-6f), r1 = __builtin_amdgcn_rsqf((float)(((unsigned long long)lo.w << 32) | lo.z) * k + 1e-6f);
            const float r2 = __builtin_amdgcn_rsqf((float)(((unsigned long long)hi.y << 32) | hi.x) * k + 1e-6f), r3 = __builtin_amdgcn_rsqf((float)(((unsigned long long)hi.w << 32) | hi.z) * k + 1e-6f);
            *(PG8_LAS f32x4*)(hstab + tid * 4) = (f32x4){r0 / r1, r1 / r2, r2 / r3, r3}; } }
#pragma unroll 1
        for (int t = 0; t < nt; t += 2) {
            const bool last = (t == nt - 2);
            if constexpr (HS) { if (t == 8 || t == 16 || t == 24) { const int hq = (t >> 3) - 1;
#pragma unroll
                for (int ai = 0; ai < 2; ++ai)
#pragma unroll
                    for (int m = 0; m < 4; ++m) { const float q = hstab[(ai * HALF + wr * 64 + m * 16 + fr) * 4 + hq];
#pragma unroll
                        for (int bj = 0; bj < 2; ++bj)
#pragma unroll
                            for (int n = 0; n < 2; ++n) acc[ai][bj][m][n] = acc[ai][bj][m][n] * q; } } }
            const char* a1 = Ab + (size_t)(t + 1) * kstep;
            const char* a2 = last ? Ab : Ab + (size_t)(t + 2) * kstep; const char* b2 = last ? nB : cB + (size_t)(t + 2) * kstepB;
            const char* a3 = a2 + kstep; const char* b3 = b2 + kstepB;
            unsigned o2[2][2];
#pragma unroll
            for (int h = 0; h < 2; ++h)
#pragma unroll
                for (int i = 0; i < 2; ++i) o2[h][i] = last ? offN[h][i] : offC[h][i];
            if constexpr (BAL) {
            const char* b1 = cB + (size_t)(t + 1) * kstepB;
            PG8_LDB(B0, 0, 0); PG8_LDB(B1, 0, 1); PG8_SCHED; PG8_LDA(At, 0, 0); PG8_STAGE(PG8_SA(1, 1), a1, offC[1]); PG8_STAGE(PG8_SB(1, 1), b1 + hstep, voffB);
            PG8_WAIT_V(8); PG8_WAIT_L(0); PG8_BAR; PG8_MMA(0, 0, At, B0); PG8_MMA(0, 1, At, B1); PG8_BAR; PG8_SCHED;
            PG8_LDA(At, 0, 1); PG8_STAGE(PG8_SB(0, 0), b2, voffB); PG8_STAGE(PG8_SA(0, 0), a2, o2[0]);
            PG8_WAIT_V(4); PG8_WAIT_L(0); PG8_BAR; PG8_MMA(1, 0, At, B0); PG8_MMA(1, 1, At, B1); PG8_BAR; PG8_SCHED;
            PG8_LDB(B0, 1, 0); PG8_LDB(B1, 1, 1); PG8_SCHED; PG8_LDA(At, 1, 0); PG8_STAGE(PG8_SA(0, 1), a2, o2[1]); PG8_STAGE(PG8_SB(0, 1), b2 + hstep, voffB);
            PG8_WAIT_V(8); PG8_WAIT_L(0); PG8_BAR; PG8_MMA(0, 0, At, B0); PG8_MMA(0, 1, At, B1); PG8_BAR; PG8_SCHED;
            PG8_LDA(At, 1, 1); PG8_STAGE(PG8_SB(1, 0), b3, voffB); PG8_STAGE(PG8_SA(1, 0), a3, o2[0]);
            PG8_WAIT_V(4); PG8_WAIT_L(0); PG8_BAR; PG8_MMA(1, 0, At, B0); PG8_MMA(1, 1, At, B1); PG8_BAR; PG8_SCHED;
            } else {
            PG8_LDB(B0, 0, 0); PG8_LDB(B1, 0, 1); PG8_SCHED; PG8_LDA(At, 0, 0); PG8_STAGE(PG8_SA(1, 1), a1, offC[1]);
            PG8_WAIT_V(8); PG8_WAIT_L(0); PG8_BAR; PG8_MMA(0, 0, At, B0); PG8_MMA(0, 1, At, B1); PG8_BAR; PG8_SCHED;
            PG8_LDA(At, 0, 1); PG8_STAGE(PG8_SB(0, 0), b2, voffB); PG8_STAGE(PG8_SB(0, 1), b2 + hstep, voffB); PG8_STAGE(PG8_SA(0, 0), a2, o2[0]);
            PG8_WAIT_V(8); PG8_WAIT_L(0); PG8_BAR; PG8_MMA(1, 0, At, B0); PG8_MMA(1, 1, At, B1); PG8_BAR; PG8_SCHED;
            PG8_LDB(B0, 1, 0); PG8_LDB(B1, 1, 1); PG8_SCHED; PG8_LDA(At, 1, 0); PG8_STAGE(PG8_SA(0, 1), a2, o2[1]);
            PG8_WAIT_V(8); PG8_WAIT_L(0); PG8_BAR; PG8_MMA(0, 0, At, B0); PG8_MMA(0, 1, At, B1); PG8_BAR; PG8_SCHED;
            PG8_LDA(At, 1, 1); PG8_STAGE(PG8_SB(1, 0), b3, voffB); PG8_STAGE(PG8_SB(1, 1), b3 + hstep, voffB); PG8_STAGE(PG8_SA(1, 0), a3, o2[0]);
            PG8_WAIT_V(8); PG8_WAIT_L(0); PG8_BAR; PG8_MMA(1, 0, At, B0); PG8_MMA(1, 1, At, B1); PG8_BAR; PG8_SCHED;
            }
        }
        if constexpr (HS) {
#pragma unroll
            for (int ai = 0; ai < 2; ++ai)
#pragma unroll
                for (int m = 0; m < 4; ++m) { const float q = hstab[(ai * HALF + wr * 64 + m * 16 + fr) * 4 + 3];
#pragma unroll
                    for (int bj = 0; bj < 2; ++bj)
#pragma unroll
                        for (int n = 0; n < 2; ++n) acc[ai][bj][m][n] = acc[ai][bj][m][n] * q; } }
        if constexpr (F8) asm volatile("s_nop 15\n\ts_nop 15" ::: "memory");
        if (wr == 0) PG8_BAR;
        E(acc, cur, wr, wc, fr, fq);
        if (!has_next) break;
#pragma unroll
        for (int a = 0; a < 2; ++a)
#pragma unroll
            for (int b = 0; b < 2; ++b)
#pragma unroll
                for (int m = 0; m < 4; ++m)
#pragma unroll
                    for (int n = 0; n < 2; ++n) acc[a][b][m][n] = (f32x4){0.f, 0.f, 0.f, 0.f};
        cur = nxt; cB = nB; ++ui;
#pragma unroll
        for (int h = 0; h < 2; ++h)
#pragma unroll
            for (int i = 0; i < 2; ++i) offC[h][i] = offN[h][i];
        if (wr == 1) PG8_BAR;
    }
    PG8_WAIT_V(0);
    PG8_BAR;
#undef PG8_SA
#undef PG8_SB
#undef PG8_STAGE
#undef PG8_LDA
#undef PG8_LDB
#undef PG8_MMA
#undef PG8_LD8
#undef PG8_WAIT_V
#undef PG8_WAIT_L
#undef PG8_BAR
#undef PG8_SCHED
}
}

constexpr int NWAVES = 8;
#ifndef MK_PER_PHASE
#define MK_PER_PHASE 0
#endif
constexpr int BATCH = 8, SEQ = 8192, D = 1024, T = BATCH * SEQ;
constexpr int RH = 4, DK = 256, DV = 512, CH = 128, NCH = SEQ / CH;
constexpr int FF = 3584, NE = 8;
constexpr float EPS = 1e-6f;
constexpr int NPH = 17;
#ifndef MK_FFN8
#define MK_FFN8 0
#endif
constexpr bool FFN8 = MK_FFN8 != 0;
constexpr float W8_SCALE = 32.0f, H8_SCALE = 8.0f, Y8_SCALE = 16.0f;

constexpr size_t MiB = 1u << 20;
constexpr size_t WS_CTL = 0, CTL_ZERO_BYTES = 4 * MiB;
constexpr size_t WS_SSQH = 2 * MiB;
constexpr size_t WS_SSQ1 = 1 * MiB, WS_SSQ2 = WS_SSQ1 + 512 * 1024;
constexpr size_t WS_WRIN = 4 * MiB;
constexpr size_t WS_WROUT = WS_WRIN + 12 * MiB;
constexpr size_t WS_WFGU = WS_WROUT + 4 * MiB;
constexpr size_t WS_WFD = WS_WFGU + 14 * MiB;
constexpr size_t WS_WCIN = WS_WFD + 7 * MiB;
constexpr size_t WS_WCOUT = WS_WCIN + 6 * MiB;
constexpr size_t WS_WMGU = WS_WCOUT + 2 * MiB;
constexpr size_t WS_WMD = WS_WMGU + 112 * MiB;
constexpr size_t WS_ROPE = WS_WMD + 56 * MiB;
constexpr size_t WS_E01 = WS_ROPE + 8 * MiB;
constexpr size_t WS_W01 = WS_E01 + 256 * 1024;
constexpr size_t WS_POS = WS_W01 + 512 * 1024;
constexpr int NPMAX = 2 * T + NE * 256;
constexpr size_t WS_IDX = WS_POS + 512 * 1024;
constexpr size_t WS_GW = WS_IDX + 1 * MiB;
constexpr size_t WS_PRS = WS_GW + 1 * MiB;
constexpr size_t WS_RSTD3 = WS_PRS + 1 * MiB;
constexpr size_t WS_ACT = 232 * MiB;
static_assert(WS_RSTD3 + 256 * 1024 <= WS_ACT, "fixed region");
constexpr size_t SLOT = 128 * MiB;
constexpr size_t WS_A0 = WS_ACT, WS_A1 = WS_ACT + SLOT, WS_A2 = WS_ACT + 2 * SLOT, WS_A3 = WS_ACT + 3 * SLOT, WS_A4 = WS_ACT + 4 * SLOT, WS_A5 = WS_ACT + 5 * SLOT;
constexpr size_t WS_END = 1024 * MiB;
constexpr size_t WS_YP = WS_A1;
constexpr size_t WS_A8 = WS_A1 + 132 * MiB;
constexpr size_t WS_HM = WS_A1 + 196 * MiB;
constexpr int HM_TILES = (int)((WS_END - WS_HM) / ((size_t)256 * FF));
static_assert(HM_TILES >= NPMAX / 256, "the whole MoE hidden must fit");
constexpr int CW_BAR = 4096;
constexpr int CW_MOE = 131072;
#define XCD_BAR_WORDS 3456
static_assert((CW_BAR + NPH * XCD_BAR_WORDS) <= CW_MOE && (CW_MOE + 16 * 64) * 4 <= (int)CTL_ZERO_BYTES, "ctl");

constexpr int RING_BYTES = 131072;
constexpr int LDS_BYTES = 163840;
constexpr int MISC_OFF = LDS_BYTES - 512;

#define GAS __attribute__((address_space(1)))
#define LAS __attribute__((address_space(3)))
typedef unsigned short bf16;
typedef unsigned v4u __attribute__((ext_vector_type(4)));
typedef unsigned v2u __attribute__((ext_vector_type(2)));
typedef float f32x4 __attribute__((ext_vector_type(4)));
typedef float f32x2 __attribute__((ext_vector_type(2)));
typedef short bf16x8 __attribute__((ext_vector_type(8)));
typedef short bf16x4 __attribute__((ext_vector_type(4)));
#define LDS_WAIT() asm volatile("s_waitcnt lgkmcnt(0)" ::: "memory")
__device__ __forceinline__ unsigned f2bf(float f) { unsigned u = __builtin_bit_cast(unsigned, f); return (u + 0x7fffu + ((u >> 16) & 1u)) >> 16; }
__device__ __forceinline__ unsigned pk2(float lo, float hi) { return f2bf(lo) | (f2bf(hi) << 16); }
typedef __bf16 bf16c2 __attribute__((ext_vector_type(2)));
__device__ __forceinline__ unsigned pk2c(float lo, float hi) { const f32x2 f = {lo, hi}; return __builtin_bit_cast(unsigned, __builtin_convertvector(f, bf16c2)); }
__device__ __forceinline__ float bflo(unsigned w) { return __builtin_bit_cast(float, w << 16); }
__device__ __forceinline__ float bfhi(unsigned w) { return __builtin_bit_cast(float, w & 0xffff0000u); }

#define XB_TMO      128
#define XB_XCNT(j)  (256  + 64 * (j))
#define XB_XSUB(j)  (1280 + 64 * (j))
#define XB_XGEN(j)  (2304 + 64 * (j))
#define XB_TOP      3328
#define XB_TOPGEN   3392
#define XB_SPIN_CAP (1u << 18)
__device__ __forceinline__ unsigned xb_ld(unsigned* p)              { return __hip_atomic_load(p, __ATOMIC_RELAXED, __HIP_MEMORY_SCOPE_AGENT); }
__device__ __forceinline__ unsigned xb_add(unsigned* p, unsigned v) { return __hip_atomic_fetch_add(p, v, __ATOMIC_RELAXED, __HIP_MEMORY_SCOPE_AGENT); }
__device__ __forceinline__ unsigned xb_xcc_id() { return (unsigned)__builtin_amdgcn_s_getreg((3 << 11) | 20) & 0xFu; }
#define XB_SPIN(cond, bar) do { unsigned _sp = 0; while (cond) { __builtin_amdgcn_s_sleep(1); \
    if ((++_sp & 255u) == 0u) { if (xb_ld(&(bar)[XB_TMO])) break; if (_sp > XB_SPIN_CAP) { atomicAdd(&(bar)[XB_TMO], 1u); break; } } } } while (0)
struct XcdBarrier { unsigned* bar; unsigned x; volatile LAS unsigned* st; };
__device__ __forceinline__ XcdBarrier xcd_barrier_post(unsigned* bar, volatile LAS unsigned* st) {
    XcdBarrier b; b.bar = bar; b.x = xb_xcc_id(); b.st = st;
    if (threadIdx.x == 0) st[2] = xb_add(&bar[XB_XCNT(b.x)], 1u);
    return b;
}
__device__ __forceinline__ void xcd_barrier_complete(unsigned* bar, unsigned x, unsigned& nloc, unsigned& nx) {
    const unsigned G = gridDim.x * gridDim.y * gridDim.z;
    unsigned sum, cnt, mine, sp = 0u;
    for (;;) {
        sum = 0u; cnt = 0u; mine = 0u;
#pragma unroll
        for (unsigned j = 0; j < 16; ++j) { const unsigned c = xb_ld(&bar[XB_XCNT(j)]); sum += c; cnt += (c > 0u) ? 1u : 0u; mine = (j == x) ? c : mine; }
        if (sum == G) break;
        __builtin_amdgcn_s_sleep(1);
        if ((++sp & 255u) == 0u) { if (xb_ld(&bar[XB_TMO])) break; if (sp > XB_SPIN_CAP) { atomicAdd(&bar[XB_TMO], 1u); break; } }
    }
    nloc = mine > 0u ? mine : 1u; nx = cnt > 0u ? cnt : 1u;
}
__device__ __forceinline__ void xcd_barrier(const XcdBarrier& b) {
    asm volatile("s_waitcnt vmcnt(0)" ::: "memory");
    __syncthreads();
    if (threadIdx.x == 0) {
        unsigned* bar = b.bar;
        __builtin_amdgcn_s_waitcnt(0);
        unsigned nloc = b.st[0], nx = b.st[1];
        if (nloc == 0u) { xcd_barrier_complete(bar, b.x, nloc, nx); b.st[0] = nloc; b.st[1] = nx; }
        const unsigned old = xb_add(&bar[XB_XSUB(b.x)], 1u);
        const unsigned gen = old / nloc;
        if (old + 1u == (gen + 1u) * nloc) {
            __builtin_amdgcn_fence(__ATOMIC_RELEASE, "agent");
            asm volatile("s_waitcnt vmcnt(0)" ::: "memory");
            const unsigned og = xb_add(&bar[XB_TOP], 1u);
            const unsigned tg = og / nx;
            if (og + 1u == (tg + 1u) * nx) xb_add(&bar[XB_TOPGEN], 1u);
            else XB_SPIN(xb_ld(&bar[XB_TOPGEN]) == tg, bar);
            __builtin_amdgcn_fence(__ATOMIC_ACQUIRE, "agent");
            xb_add(&bar[XB_XGEN(b.x)], 1u);
            asm volatile("s_waitcnt vmcnt(0)" ::: "memory");
        } else {
            XB_SPIN(xb_ld(&bar[XB_XGEN(b.x)]) == gen, bar);
            __builtin_amdgcn_fence(__ATOMIC_ACQUIRE, "agent");
            asm volatile("s_waitcnt vmcnt(0)" ::: "memory");
        }
    }
    __syncthreads();
}

struct Frame {
    LAS unsigned char* lds;
    unsigned* ctl;
    int tid, lane, wave, vcu, vcu2, G;
    const float* in[18];
    float* out; unsigned char* ws;
};
__device__ __forceinline__ int opq(int v) { asm volatile("" : "+v"(v)); return v; }
__device__ __forceinline__ float wave_sum(float v) {
#pragma unroll
    for (int o = 1; o < 64; o <<= 1) v += __shfl_xor(v, o);
    return v;
}

__device__ __forceinline__ void p0_transpose_item(const float* W, int K, int N, bf16* WT, int mode, LAS float* scr, int item, int lane, const float* gain = nullptr) {
    const int nblk = N / 32, kb = item / nblk, nb = item % nblk, k0 = 64 * kb, n0 = 32 * nb;
    const int drow0 = mode == 0 ? n0 : mode == 3 ? (n0 < 1024 ? n0 : n0 < 2048 ? 1024 + ((n0 - 1024) >> 7) * 256 + ((n0 - 1024) & 127) : 1024 + ((n0 - 2048) >> 7) * 256 + 128 + ((n0 - 2048) & 127))
                                  : ((n0 >> 7) * 256 + (n0 & 127) + (mode == 2 ? 128 : 0));
    { const int r = lane >> 3, c4 = lane & 7; f32x4 v[8];
#pragma unroll
      for (int i = 0; i < 8; ++i) v[i] = *(const GAS f32x4*)(W + (size_t)(k0 + 8 * i + r) * N + n0 + 4 * c4);
#pragma unroll
      for (int i = 0; i < 8; ++i) { const float gsc = gain ? gain[k0 + 8 * i + r] : 1.0f; LAS float* d = scr + (8 * i + r) * 33 + 4 * c4;
          d[0] = v[i].x * gsc; d[1] = v[i].y * gsc; d[2] = v[i].z * gsc; d[3] = v[i].w * gsc; } }
    LDS_WAIT(); asm volatile("" ::: "memory");
    const int c = lane & 7;
    unsigned char* img = (unsigned char*)WT + ((size_t)((drow0 >> 8) * 2 + ((drow0 >> 7) & 1)) * (K / 64) + kb) * 16384;
#pragma unroll
    for (int j = 0; j < 4; ++j) { const int n = (lane >> 3) + 8 * j; const LAS float* s = scr + (8 * c) * 33 + n;
        v4u o; o.x = pk2(s[0 * 33], s[1 * 33]); o.y = pk2(s[2 * 33], s[3 * 33]); o.z = pk2(s[4 * 33], s[5 * 33]); o.w = pk2(s[6 * 33], s[7 * 33]);
        const int slot = 16 * ((n >> 2) & 1) + 4 * (n >> 3) + (n & 3), R = (drow0 & 96) + slot;
        *(GAS v4u*)(img + pg8::lds_byte(R, 8 * c)) = o; }
    LDS_WAIT(); asm volatile("" ::: "memory");
}
__device__ __forceinline__ void p0_item_f8(const float* W, int K, int N, unsigned char* WT, int mode, LAS float* scr, int item, int lane, const float* gain, float scale) {
    const int nblk = N / 32, kb = item / nblk, nb = item % nblk, k0 = 64 * kb, n0 = 32 * nb;
    const int drow0 = mode == 0 ? n0 : ((n0 >> 7) * 256 + (n0 & 127) + (mode == 2 ? 128 : 0));
    { const int r = lane >> 3, c4 = lane & 7; f32x4 v[8];
#pragma unroll
      for (int i = 0; i < 8; ++i) v[i] = *(const GAS f32x4*)(W + (size_t)(k0 + 8 * i + r) * N + n0 + 4 * c4);
#pragma unroll
      for (int i = 0; i < 8; ++i) { const float gsc = (gain ? gain[k0 + 8 * i + r] : 1.0f) * scale; LAS float* d = scr + (8 * i + r) * 33 + 4 * c4;
          d[0] = v[i].x * gsc; d[1] = v[i].y * gsc; d[2] = v[i].z * gsc; d[3] = v[i].w * gsc; } }
    LDS_WAIT(); asm volatile("" ::: "memory");
    const int c = lane & 7;
    unsigned char* img = WT + ((size_t)((drow0 >> 8) * 2 + ((drow0 >> 7) & 1)) * (K / 128) + (k0 >> 7)) * 16384;
#pragma unroll
    for (int j = 0; j < 4; ++j) { const int n = (lane >> 3) + 8 * j; const LAS float* s = scr + (8 * c) * 33 + n;
        v2u o; o.x = pg8::pk4_fp8(s[0 * 33], s[1 * 33], s[2 * 33], s[3 * 33]); o.y = pg8::pk4_fp8(s[4 * 33], s[5 * 33], s[6 * 33], s[7 * 33]);
        const int slot = 16 * ((n >> 2) & 1) + 4 * (n >> 3) + (n & 3), R = (drow0 & 96) + slot;
        *(GAS v2u*)(img + pg8::lds_byteB(R, (k0 & 127) + 8 * c)) = o; }
    LDS_WAIT(); asm volatile("" ::: "memory");
}
__device__ __forceinline__ void norm_phase(Frame& F, const float* src, const float* gain, bf16* dst) {
    const int tid_ = opq(F.tid), lane_ = tid_ & 63;
    const int gw = F.vcu * NWAVES + F.wave, NGW = F.G * NWAVES, lane = lane_;
    f32x4 gg[4];
#pragma unroll
    for (int j = 0; j < 4; ++j) gg[j] = ((const GAS f32x4*)gain + lane)[64 * j];
    for (int m = 2 * gw; m < T; m += 2 * NGW) {
        const GAS f32x4* xa = (const GAS f32x4*)(src + (size_t)m * D) + lane; const GAS f32x4* xb = xa + D / 4;
        f32x4 va[4], vb[4]; float sa = 0.f, sb = 0.f;
#pragma unroll
        for (int j = 0; j < 4; ++j) { va[j] = xa[64 * j]; vb[j] = xb[64 * j]; }
#pragma unroll
        for (int j = 0; j < 4; ++j) { sa += (va[j].x * va[j].x + va[j].y * va[j].y) + (va[j].z * va[j].z + va[j].w * va[j].w); sb += (vb[j].x * vb[j].x + vb[j].y * vb[j].y) + (vb[j].z * vb[j].z + vb[j].w * vb[j].w); }
        const float ra = 1.0f / sqrtf(wave_sum(sa) * (1.f / D) + EPS), rb = 1.0f / sqrtf(wave_sum(sb) * (1.f / D) + EPS);
        GAS v2u* oa = (GAS v2u*)(dst + (size_t)m * D) + lane; GAS v2u* ob = oa + D / 4;
#pragma unroll
        for (int j = 0; j < 4; ++j) { v2u w; w.x = pk2(va[j].x * ra * gg[j].x, va[j].y * ra * gg[j].y); w.y = pk2(va[j].z * ra * gg[j].z, va[j].w * ra * gg[j].w); oa[64 * j] = w;
            v2u w2; w2.x = pk2(vb[j].x * rb * gg[j].x, vb[j].y * rb * gg[j].y); w2.y = pk2(vb[j].z * rb * gg[j].z, vb[j].w * rb * gg[j].w); ob[64 * j] = w2; }
    }
}
__device__ __forceinline__ void p0_prologue(Frame& F) {
    const int tid_ = opq(F.tid), lane_ = tid_ & 63;
    LAS float* scr = (LAS float*)(F.lds + F.wave * 16384);
    const int gw = F.vcu * NWAVES + F.wave, NGW = F.G * NWAVES;
    constexpr int I_RIN = 16 * 192, I_ROUT = 32 * 32, I_FG = 16 * 112, I_FD = 56 * 32, I_CIN = 16 * 96, I_COUT = 16 * 32;
    constexpr int NITEMS = I_RIN + I_ROUT + 2 * I_FG + I_FD + I_CIN + I_COUT + 8 * (2 * I_FG + I_FD);
    unsigned char* ws = F.ws;
    for (int it = gw; it < NITEMS; it += NGW) {
        int r = it;
        if (r < I_RIN) { p0_transpose_item(F.in[2], 1024, 6144, (bf16*)(ws + WS_WRIN), 0, scr, r, lane_); continue; } r -= I_RIN;
        if (r < I_ROUT) { p0_transpose_item(F.in[3], 2048, 1024, (bf16*)(ws + WS_WROUT), 0, scr, r, lane_); continue; } r -= I_ROUT;
        if (r < I_FG) { p0_transpose_item(F.in[5], 1024, FF, (bf16*)(ws + WS_WFGU), 1, scr, r, lane_, F.in[4]); continue; } r -= I_FG;
        if (r < I_FG) { p0_transpose_item(F.in[6], 1024, FF, (bf16*)(ws + WS_WFGU), 2, scr, r, lane_, F.in[4]); continue; } r -= I_FG;
        if (r < I_FD) { if (FFN8) p0_item_f8(F.in[7], FF, 1024, ws + WS_WFD, 0, scr, r, lane_, nullptr, W8_SCALE); else p0_transpose_item(F.in[7], FF, 1024, (bf16*)(ws + WS_WFD), 0, scr, r, lane_); continue; } r -= I_FD;
        if (r < I_CIN) { p0_transpose_item(F.in[9], 1024, 3072, (bf16*)(ws + WS_WCIN), 3, scr, r, lane_, F.in[8]); continue; } r -= I_CIN;
        if (r < I_COUT) { p0_transpose_item(F.in[11], 1024, 1024, (bf16*)(ws + WS_WCOUT), 0, scr, r, lane_); continue; } r -= I_COUT;
        if (r < 8 * I_FG) { const int e = r / I_FG; p0_item_f8(F.in[14] + (size_t)e * 1024 * FF, 1024, FF, ws + WS_WMGU + (size_t)e * 7168 * 1024, 1, scr, r % I_FG, lane_, F.in[12], W8_SCALE); continue; } r -= 8 * I_FG;
        if (r < 8 * I_FG) { const int e = r / I_FG; p0_item_f8(F.in[15] + (size_t)e * 1024 * FF, 1024, FF, ws + WS_WMGU + (size_t)e * 7168 * 1024, 2, scr, r % I_FG, lane_, F.in[12], W8_SCALE); continue; } r -= 8 * I_FG;
        { const int e = r / I_FD; p0_item_f8(F.in[16] + (size_t)e * FF * 1024, FF, 1024, ws + WS_WMD + (size_t)e * 1024 * FF, 0, scr, r % I_FD, lane_, nullptr, W8_SCALE); }
    }
    {
        const int gt = F.vcu * (NWAVES * 64) + tid_, NT_ = F.G * (NWAVES * 64);
        const int jg = gt & 31, j0 = 4 * jg; float ivf[4];
#pragma unroll
        for (int x = 0; x < 4; ++x) ivf[x] = (float)exp(-(double)(2 * (j0 + x)) * (1.0 / 256.0) * 9.210340371976184);
        const int twc = j0 >> 5, tfq = (j0 & 31) >> 3, thalf = (j0 & 7) >> 2;
        for (int it = gt; it < 8192 * 32; it += NT_) { const int pos = it >> 5; f32x4 cs, sn;
#pragma unroll
            for (int x = 0; x < 4; ++x) { const float ang = (float)pos * ivf[x];
                const float pr = ang * 0.15915494f, er = __builtin_fmaf(ang, 0.15915494f, -pr) + ang * 6.4206382e-9f;
                const float t = (pr - __builtin_floorf(pr)) + er;
                cs[x] = __builtin_amdgcn_cosf(t); sn[x] = __builtin_amdgcn_sinf(t); }
            float* tb = (float*)(ws + WS_ROPE) + ((((size_t)(pos >> 4) * 4 + twc) * 4) * 64 + tfq * 16 + (pos & 15)) * 4;
            *(f32x4*)(tb + thalf * 256) = cs; *(f32x4*)(tb + (2 + thalf) * 256) = sn; } }
    norm_phase(F, F.in[0], F.in[1], (bf16*)(ws + WS_A0));
}

constexpr int KS_STRIDE = 544, VS_STRIDE = 160, ST_STRIDE = 544;
constexpr int KS_OFF = 0, VS_OFF = 128 * KS_STRIDE, ST_OFF = VS_OFF + 128 * VS_STRIDE, SCAN_LDS = ST_OFF + 64 * ST_STRIDE;
static_assert(SCAN_LDS <= RING_BYTES, "scan LDS");
constexpr int ST2_BYTES = 64 * ST_STRIDE;
static_assert(ST_OFF + 2 * ST2_BYTES <= MISC_OFF, "scan LDS (two state images)");
template <int O0, int O1, int O2, int O3, int O4, int O5, int O6, int O7>
__device__ __forceinline__ void tr8(unsigned base, bf16x4& r0, bf16x4& r1, bf16x4& r2, bf16x4& r3, bf16x4& r4, bf16x4& r5, bf16x4& r6, bf16x4& r7) {
    asm volatile("ds_read_b64_tr_b16 %0, %8 offset:%9\n\tds_read_b64_tr_b16 %1, %8 offset:%10\n\tds_read_b64_tr_b16 %2, %8 offset:%11\n\tds_read_b64_tr_b16 %3, %8 offset:%12\n\t"
                 "ds_read_b64_tr_b16 %4, %8 offset:%13\n\tds_read_b64_tr_b16 %5, %8 offset:%14\n\tds_read_b64_tr_b16 %6, %8 offset:%15\n\tds_read_b64_tr_b16 %7, %8 offset:%16\n\ts_waitcnt lgkmcnt(0)"
                 : "=&v"(r0), "=&v"(r1), "=&v"(r2), "=&v"(r3), "=&v"(r4), "=&v"(r5), "=&v"(r6), "=&v"(r7)
                 : "v"(base), "n"(O0), "n"(O1), "n"(O2), "n"(O3), "n"(O4), "n"(O5), "n"(O6), "n"(O7) : "memory");
}
__device__ __forceinline__ bf16x8 cat8(bf16x4 a, bf16x4 b) { return (bf16x8){a[0], a[1], a[2], a[3], b[0], b[1], b[2], b[3]}; }
template <int KS> __device__ __forceinline__ void load_vf(unsigned vbase, bf16x8& f0, bf16x8& f1, bf16x8& f2, bf16x8& f3) {
    constexpr int B = KS * 32 * VS_STRIDE, T1 = 16 * VS_STRIDE;
    bf16x4 a0, a1, b0, b1, c0, c1, d0, d1;
    tr8<B, B + T1, B + 32, B + 32 + T1, B + 64, B + 64 + T1, B + 96, B + 96 + T1>(vbase, a0, a1, b0, b1, c0, c1, d0, d1);
    f0 = cat8(a0, a1); f1 = cat8(b0, b1); f2 = cat8(c0, c1); f3 = cat8(d0, d1);
}
template <int DB> __device__ __forceinline__ void load_kf(unsigned kbase, bf16x8& f0, bf16x8& f1, bf16x8& f2, bf16x8& f3) {
    constexpr int B = DB * 32, S = 32 * KS_STRIDE, T1 = 16 * KS_STRIDE;
    bf16x4 a0, a1, b0, b1, c0, c1, d0, d1;
    tr8<B, B + T1, B + S, B + S + T1, B + 2 * S, B + 2 * S + T1, B + 3 * S, B + 3 * S + T1>(kbase, a0, a1, b0, b1, c0, c1, d0, d1);
    f0 = cat8(a0, a1); f1 = cat8(b0, b1); f2 = cat8(c0, c1); f3 = cat8(d0, d1);
}
#define SC_SCHED __builtin_amdgcn_sched_barrier(0)
#define SC_BAR asm volatile("s_waitcnt lgkmcnt(0)\n\ts_barrier" ::: "memory")
#define SC_TR(p) __builtin_amdgcn_ds_read_tr16_b64_v4i16((LAS bf16x4*)(p))
template <int V, bool DRY> __device__ __forceinline__ void scan3_owave(LAS unsigned char* lds, const bf16* Qg, const bf16* Gg, bf16* Vg, unsigned long long* ssqh, size_t seq0, int h, int s, int lane, size_t seq0o) {
    constexpr int rbA = V, rbB = 7 - V;
    const int r16 = lane & 15, g4 = lane >> 4, trq = (lane & 15) >> 2, trp = lane & 3;
    const bf16* QpA = Qg + ((seq0 >> 4) + rbA) * 16384 + h * 4096 + lane * 8; const bf16* QpB = Qg + ((seq0 >> 4) + rbB) * 16384 + h * 4096 + lane * 8;
    const int gq = (g4 >> 1) + 2 * (g4 & 1), gpos = (r16 * 64 + gq * 16) ^ ((r16 >> 3) << 5);
    const size_t orowA = ((seq0 >> 7) * 32 + 8 * h + s) * (size_t)pg8::HTB + rbA * 2048 + gpos, orowB = ((seq0 >> 7) * 32 + 8 * h + s) * (size_t)pg8::HTB + rbB * 2048 + gpos;
    unsigned long long* SSpA = ssqh + (seq0o + 16 * rbA + r16) * 4 + h; unsigned long long* SSpB = ssqh + (seq0o + 16 * rbB + r16) * 4 + h;
    const size_t srowA = ((seq0o >> 7) * 32 + 8 * h + s) * (size_t)pg8::HTB + rbA * 2048 + gpos, srowB = ((seq0o >> 7) * 32 + 8 * h + s) * (size_t)pg8::HTB + rbB * 2048 + gpos;
    LAS unsigned char* kq = lds + KS_OFF + r16 * KS_STRIDE + g4 * 16;
    LAS unsigned char* vq = lds + VS_OFF + (4 * g4 + trq) * VS_STRIDE + 8 * trp;
    f32x4 U[16];
#define QFA(ks) __builtin_bit_cast(bf16x8, U[ks])
#define QFB(ks) __builtin_bit_cast(bf16x8, U[8 + (ks)])
#pragma unroll
    for (int ks = 0; ks < 8; ++ks) { U[ks] = __builtin_bit_cast(f32x4, *(const GAS bf16x8*)(QpA + 512 * ks)); U[8 + ks] = __builtin_bit_cast(f32x4, *(const GAS bf16x8*)(QpB + 512 * ks)); }
#pragma unroll 1
    for (int n = 0; n < NCH; ++n) {
        const int nn = (n + 1 < NCH) ? n + 1 : n;
        LAS unsigned char* sq = lds + ST_OFF + (n & 1) * ST2_BYTES + r16 * ST_STRIDE + g4 * 16;
        SC_BAR;
        bf16x8 kf[2][8], sf[2][4], vf[2][4];
#define SC_LOADK(buf, jb) do { _Pragma("unroll") for (int kk = 0; kk < 8; ++kk) kf[buf][kk] = *(const LAS bf16x8*)(kq + (jb) * 16 * KS_STRIDE + kk * 64); } while (0)
#define SC_LOADS(buf, ks) do { _Pragma("unroll") for (int eb = 0; eb < 4; ++eb) sf[buf][eb] = *(const LAS bf16x8*)(sq + eb * 16 * ST_STRIDE + (ks) * 64); } while (0)
#define SC_LOADV(buf, KS) do { _Pragma("unroll") for (int eb = 0; eb < 4; ++eb) vf[buf][eb] = cat8(SC_TR(vq + (KS) * 32 * VS_STRIDE + 32 * eb), SC_TR(vq + (KS) * 32 * VS_STRIDE + 32 * eb + 16 * VS_STRIDE)); } while (0)
        v4u pwA[4], pwB[4];
#pragma unroll
        for (int ks = 0; ks < 4; ++ks) { pwA[ks] = (v4u){0u, 0u, 0u, 0u}; pwB[ks] = (v4u){0u, 0u, 0u, 0u}; }
        SC_LOADK(0, 0);
#pragma unroll
        for (int jb = 0; jb <= rbB; ++jb) {
            if (jb < rbB) SC_LOADK((jb + 1) & 1, jb + 1); else SC_LOADS(0, 0);
            SC_SCHED;
            f32x4 sa = (f32x4){0.f, 0.f, 0.f, 0.f}, sb = (f32x4){0.f, 0.f, 0.f, 0.f};
#pragma unroll
            for (int kk = 0; kk < 8; ++kk) { sb = __builtin_amdgcn_mfma_f32_16x16x32_bf16(kf[jb & 1][kk], QFB(kk), sb, 0, 0, 0);
                if (jb <= rbA) sa = __builtin_amdgcn_mfma_f32_16x16x32_bf16(kf[jb & 1][kk], QFA(kk), sa, 0, 0, 0); }
            if (jb == rbB) {
#pragma unroll
                for (int x = 0; x < 4; ++x) if (4 * g4 + x > r16) sb[x] = 0.f; }
            if (jb == rbA) {
#pragma unroll
                for (int x = 0; x < 4; ++x) if (4 * g4 + x > r16) sa[x] = 0.f; }
            if ((jb & 1) == 0) { pwB[jb >> 1].x = pk2c(sb[0], sb[1]); pwB[jb >> 1].y = pk2c(sb[2], sb[3]); if (jb <= rbA) { pwA[jb >> 1].x = pk2c(sa[0], sa[1]); pwA[jb >> 1].y = pk2c(sa[2], sa[3]); } }
            else { pwB[jb >> 1].z = pk2c(sb[0], sb[1]); pwB[jb >> 1].w = pk2c(sb[2], sb[3]); if (jb <= rbA) { pwA[jb >> 1].z = pk2c(sa[0], sa[1]); pwA[jb >> 1].w = pk2c(sa[2], sa[3]); } }
            SC_SCHED;
        }
        v4u gvA[2], gvB[2];
#pragma unroll
        for (int ch = 0; ch < 2; ++ch) { gvA[ch] = *(const GAS v4u*)((const char*)Gg + orowA + (size_t)n * (32 * pg8::HTB) + ch * 1024); gvB[ch] = *(const GAS v4u*)((const char*)Gg + orowB + (size_t)n * (32 * pg8::HTB) + ch * 1024); }
        f32x4 OA[4], OB[4];
#pragma unroll
        for (int eb = 0; eb < 4; ++eb) { OA[eb] = (f32x4){0.f, 0.f, 0.f, 0.f}; OB[eb] = (f32x4){0.f, 0.f, 0.f, 0.f}; }
#pragma unroll
        for (int ks = 0; ks < 8; ++ks) {
            if (ks < 7) SC_LOADS((ks + 1) & 1, ks + 1); else SC_LOADV(0, 0);
            SC_SCHED;
#pragma unroll
            for (int eb = 0; eb < 4; ++eb) { OA[eb] = __builtin_amdgcn_mfma_f32_16x16x32_bf16(sf[ks & 1][eb], QFA(ks), OA[eb], 0, 0, 0); OB[eb] = __builtin_amdgcn_mfma_f32_16x16x32_bf16(sf[ks & 1][eb], QFB(ks), OB[eb], 0, 0, 0); }
            SC_SCHED;
            U[ks] = __builtin_bit_cast(f32x4, *(const GAS bf16x8*)(QpA + (size_t)nn * CH * 1024 + 512 * ks)); U[8 + ks] = __builtin_bit_cast(f32x4, *(const GAS bf16x8*)(QpB + (size_t)nn * CH * 1024 + 512 * ks));
        }
#pragma unroll
        for (int KS = 0; KS <= rbB / 2; ++KS) {
            if (KS < rbB / 2) SC_LOADV((KS + 1) & 1, KS + 1);
            SC_SCHED;
#pragma unroll
            for (int eb = 0; eb < 4; ++eb) { OB[eb] = __builtin_amdgcn_mfma_f32_16x16x32_bf16(vf[KS & 1][eb], __builtin_bit_cast(bf16x8, pwB[KS]), OB[eb], 0, 0, 0);
                if (KS <= rbA / 2) OA[eb] = __builtin_amdgcn_mfma_f32_16x16x32_bf16(vf[KS & 1][eb], __builtin_bit_cast(bf16x8, pwA[KS]), OA[eb], 0, 0, 0); }
            SC_SCHED;
        }
        SC_BAR;
#define SCAN3_STORE(OX, GV, OROW, SSP) do { float ss = 0.f; v2u gq2[4], wv[4]; \
        _Pragma("unroll") for (int ch = 0; ch < 2; ++ch) { const auto s0 = __builtin_amdgcn_permlane16_swap(GV[ch].x, GV[ch].z, false, false); const auto s1 = __builtin_amdgcn_permlane16_swap(GV[ch].y, GV[ch].w, false, false); \
            gq2[2 * ch] = (v2u){s0[0], s1[0]}; gq2[2 * ch + 1] = (v2u){s0[1], s1[1]}; }     \
        _Pragma("unroll") for (int eb = 0; eb < 4; ++eb) { const float g0 = bflo(gq2[eb].x), g1 = bfhi(gq2[eb].x), g2 = bflo(gq2[eb].y), g3 = bfhi(gq2[eb].y); \
            ss += (OX[eb][0] * OX[eb][0] + OX[eb][1] * OX[eb][1]) + (OX[eb][2] * OX[eb][2] + OX[eb][3] * OX[eb][3]); \
            wv[eb].x = pk2c(pg8::silu_f(g0) * OX[eb][0], pg8::silu_f(g1) * OX[eb][1]); wv[eb].y = pk2c(pg8::silu_f(g2) * OX[eb][2], pg8::silu_f(g3) * OX[eb][3]); } \
        _Pragma("unroll") for (int ch = 0; ch < 2; ++ch) { const v4u w = pg8::widen16(wv[2 * ch], wv[2 * ch + 1]); \
            if (!DRY || w.x == 0x12345678u) *(GAS v4u*)((char*)Vg + OROW + (size_t)n * (32 * pg8::HTB) + ch * 1024) = w; } \
        ss += __shfl_xor(ss, 16); ss += __shfl_xor(ss, 32); \
        if (!DRY && g4 == 0) __hip_atomic_fetch_add(SSP + (size_t)n * CH * 4, (unsigned long long)(ss * 4294967296.0f), __ATOMIC_RELAXED, __HIP_MEMORY_SCOPE_AGENT); } while (0)
        SCAN3_STORE(OA, gvA, srowA, SSpA); SCAN3_STORE(OB, gvB, srowB, SSpB);
#undef SCAN3_STORE
#undef SC_LOADK
#undef SC_LOADS
#undef SC_LOADV
    }
#undef QFA
#undef QFB
}
template <bool DRY> __device__ __forceinline__ void scan3_swave(LAS unsigned char* lds, const char* Kub, const char* Vub, float gC, int v, int ts, int lane) {
    const int r16 = lane & 15, g4 = lane >> 4, trq = (lane & 15) >> 2, trp = lane & 3;
    LAS unsigned char* vq = lds + VS_OFF + (4 * g4 + trq) * VS_STRIDE + 8 * trp; LAS unsigned char* kq = lds + KS_OFF + (4 * g4 + trq) * KS_STRIDE + 128 * v + 8 * trp;
    const unsigned kvo = (unsigned)(ts * 16);
    const int pr0 = (ts >> 7) * 16 + ((ts & 63) >> 2), pc0 = ((ts >> 6) & 1) * 32 + (((ts & 3) ^ (((ts >> 5) & 1) << 1)) * 8);
    LAS unsigned char* kdst = lds + KS_OFF + pr0 * KS_STRIDE + pc0 * 2; LAS unsigned char* vdst = lds + VS_OFF + pr0 * VS_STRIDE + pc0 * 2;
#define KPIECE(nch, q) (*(const GAS v4u*)(Kub + (size_t)(nch) * (16 * pg8::HTB) + (q) * 4096 + kvo))
#define VPIECE(nch, q) (*(const GAS v4u*)(Vub + (size_t)(nch) * (32 * pg8::HTB) + (q) * 4096 + kvo))
    v4u kreg[16], vreg[4];
    f32x4 U[16];
#define SACC(db, eb) U[4 * (db) + (eb)]
#pragma unroll
    for (int i = 0; i < 16; ++i) U[i] = (f32x4){0.f, 0.f, 0.f, 0.f};
#pragma unroll
    for (int q = 0; q < 16; ++q) kreg[q] = KPIECE(0, q);
#pragma unroll
    for (int q = 0; q < 4; ++q) vreg[q] = VPIECE(0, q);
#pragma unroll 1
    for (int n = 0; n < NCH; ++n) {
        const int nn = (n + 1 < NCH) ? n + 1 : n;
#pragma unroll
        for (int q = 0; q < 16; ++q) *(LAS v4u*)(kdst + (q & 3) * 32 * KS_STRIDE + (q >> 2) * 128) = kreg[q];
#pragma unroll
        for (int q = 0; q < 4; ++q) *(LAS v4u*)(vdst + q * 32 * VS_STRIDE) = vreg[q];
        SC_BAR;
#pragma unroll
        for (int q = 0; q < 16; ++q) kreg[q] = KPIECE(nn, q);
#pragma unroll
        for (int q = 0; q < 4; ++q) vreg[q] = VPIECE(nn, q);
        bf16x8 kf[1][4], vf[1][4];
#define SC_LOADKV(buf, KS) do { _Pragma("unroll") for (int j = 0; j < 4; ++j) { \
            kf[buf][j] = cat8(SC_TR(kq + 32 * j + (KS) * 32 * KS_STRIDE), SC_TR(kq + 32 * j + (KS) * 32 * KS_STRIDE + 16 * KS_STRIDE)); \
            vf[buf][j] = cat8(SC_TR(vq + (KS) * 32 * VS_STRIDE + 32 * j), SC_TR(vq + (KS) * 32 * VS_STRIDE + 32 * j + 16 * VS_STRIDE)); } } while (0)
#pragma unroll
        for (int KS = 0; KS < 4; ++KS) {
            SC_LOADKV(0, KS);
            SC_SCHED;
#pragma unroll
            for (int db = 0; db < 4; ++db)
#pragma unroll
                for (int eb = 0; eb < 4; ++eb) SACC(db, eb) = __builtin_amdgcn_mfma_f32_16x16x32_bf16(kf[0][db], vf[0][eb], SACC(db, eb), 0, 0, 0);
            SC_SCHED;
        }
#undef SC_LOADKV
        LAS unsigned char* stn = lds + ST_OFF + ((n + 1) & 1) * ST2_BYTES;
#pragma unroll
        for (int db = 0; db < 4; ++db)
#pragma unroll
            for (int eb = 0; eb < 4; ++eb) { SACC(db, eb) = SACC(db, eb) * gC; v2u wv; wv.x = pk2c(SACC(db, eb)[0], SACC(db, eb)[1]); wv.y = pk2c(SACC(db, eb)[2], SACC(db, eb)[3]);
                *(LAS v2u*)(stn + (16 * eb + r16) * ST_STRIDE + (64 * v + 16 * db + 4 * g4) * 2) = wv; }
        SC_BAR;
    }
#undef KPIECE
#undef VPIECE
#undef SACC
}
template <bool DRY, bool REDIR = false> __device__ __forceinline__ void ret_scan_phase3(Frame& F) {
    int tid_ = F.tid; asm volatile("" : "+v"(tid_));
    const int tid = tid_, w = F.wave, lane = tid & 63;
    const bf16* Qg = (const bf16*)(F.ws + WS_A1); const bf16* Kg = (const bf16*)(F.ws + WS_A2); bf16* Vg = (bf16*)(F.ws + WS_A3);
    LAS unsigned char* lds = F.lds;
    for (int unit = F.vcu2; unit < BATCH * RH * 8; unit += F.G) {
        const int s = unit & 7, bh = unit >> 3, h = bh % RH, b = bh / RH;
        const float gamma = 1.0f - exp2f(-(float)(5 + h));
        const float gC = expf(128.0f * logf(gamma));
        __syncthreads();
        for (int i = tid; i < ST2_BYTES / 4; i += NWAVES * 64) ((LAS unsigned*)(lds + ST_OFF))[i] = 0u;
        const size_t seq0 = (size_t)b * SEQ;
        unsigned long long* ssqh = REDIR ? (unsigned long long*)(F.ws + WS_A5 + 64 * MiB) : (unsigned long long*)(F.ws + WS_SSQH);
        bf16* Og = REDIR ? (bf16*)(F.ws + WS_A5) : (bf16*)F.out;     const size_t seq0o = REDIR ? (size_t)(b & 1) * SEQ : seq0;
        if (w == 0) scan3_owave<0, DRY>(lds, Qg, (const bf16*)F.out, Og, ssqh, seq0, h, s, lane, seq0o);
        else if (w == 1) scan3_owave<1, DRY>(lds, Qg, (const bf16*)F.out, Og, ssqh, seq0, h, s, lane, seq0o);
        else if (w == 2) scan3_owave<2, DRY>(lds, Qg, (const bf16*)F.out, Og, ssqh, seq0, h, s, lane, seq0o);
        else if (w == 3) scan3_owave<3, DRY>(lds, Qg, (const bf16*)F.out, Og, ssqh, seq0, h, s, lane, seq0o);
        else scan3_swave<DRY>(lds, (const char*)Kg + ((seq0 >> 7) * 16 + 4 * h) * (size_t)pg8::HTB, (const char*)Vg + ((seq0 >> 7) * 32 + 8 * h + s) * (size_t)pg8::HTB, gC, w & 3, tid & 255, lane);
    }
    __syncthreads();
}
__device__ __forceinline__ void conv_phase(Frame& F) {
    const int tid_ = opq(F.tid), lane_ = tid_ & 63;
    const bf16* Bc = (const bf16*)(F.ws + WS_A1); const bf16* Uc = (const bf16*)(F.ws + WS_A2); bf16* Z = (bf16*)(F.ws + WS_A4);
    const float* wcv = F.in[10];
    constexpr int RUN = 32;
    const int gw = F.vcu * NWAVES + F.wave, NGW = F.G * NWAVES;
    for (int it = gw; it < (T / RUN) * 2; it += NGW) {
        const int run = it >> 1, col = (it & 1) * 512 + lane_ * 8, t0 = run * RUN;
        float w0[8], w1[8], w2[8];
#pragma unroll
        for (int k = 0; k < 8; ++k) { w0[k] = wcv[col + k]; w1[k] = wcv[D + col + k]; w2[k] = wcv[2 * D + col + k]; }
        float um2[8], um1[8];
#pragma unroll
        for (int k = 0; k < 8; ++k) { um2[k] = 0.f; um1[k] = 0.f; }
        if ((t0 & (SEQ - 1)) != 0) {
            const v4u c2 = *(const GAS v4u*)(Uc + (size_t)(t0 - 2) * D + col), c1 = *(const GAS v4u*)(Uc + (size_t)(t0 - 1) * D + col);
            um2[0] = bflo(c2.x); um2[1] = bfhi(c2.x); um2[2] = bflo(c2.y); um2[3] = bfhi(c2.y); um2[4] = bflo(c2.z); um2[5] = bfhi(c2.z); um2[6] = bflo(c2.w); um2[7] = bfhi(c2.w);
            um1[0] = bflo(c1.x); um1[1] = bfhi(c1.x); um1[2] = bflo(c1.y); um1[3] = bfhi(c1.y); um1[4] = bflo(c1.z); um1[5] = bfhi(c1.z); um1[6] = bflo(c1.w); um1[7] = bfhi(c1.w);
        }
#pragma unroll 4
        for (int t = t0; t < t0 + RUN; ++t) {
            const size_t off = (size_t)t * D + col;
            const v4u cv = *(const GAS v4u*)(Uc + off), bv = *(const GAS v4u*)(Bc + off);
            float u[8], gb[8], z[8];
            u[0] = bflo(cv.x); u[1] = bfhi(cv.x); u[2] = bflo(cv.y); u[3] = bfhi(cv.y); u[4] = bflo(cv.z); u[5] = bfhi(cv.z); u[6] = bflo(cv.w); u[7] = bfhi(cv.w);
            gb[0] = bflo(bv.x); gb[1] = bfhi(bv.x); gb[2] = bflo(bv.y); gb[3] = bfhi(bv.y); gb[4] = bflo(bv.z); gb[5] = bfhi(bv.z); gb[6] = bflo(bv.w); gb[7] = bfhi(bv.w);
#pragma unroll
            for (int k = 0; k < 8; ++k) { z[k] = gb[k] * (w0[k] * um2[k] + w1[k] * um1[k] + w2[k] * u[k]); um2[k] = um1[k]; um1[k] = u[k]; }
            v4u wv; wv.x = pk2(z[0], z[1]); wv.y = pk2(z[2], z[3]); wv.z = pk2(z[4], z[5]); wv.w = pk2(z[6], z[7]);
            *(GAS v4u*)(Z + off) = wv;
        }
    }
}

__device__ __forceinline__ void router_row(const f32x4 (&v)[4], const f32x4 (&gg)[4], float rstd, const LAS float* Wr, int lane, float (&lg)[8]) {
#pragma unroll
    for (int e = 0; e < 8; ++e) lg[e] = 0.f;
#pragma unroll
    for (int j = 0; j < 4; ++j) { f32x4 y; y.x = v[j].x * rstd * gg[j].x; y.y = v[j].y * rstd * gg[j].y; y.z = v[j].z * rstd * gg[j].z; y.w = v[j].w * rstd * gg[j].w;
#pragma unroll
        for (int e = 0; e < 8; ++e) { const f32x4 wv = *(const LAS f32x4*)(Wr + e * D + 4 * lane + 256 * j);
            lg[e] += (y.x * wv.x + y.y * wv.y) + (y.z * wv.z + y.w * wv.w); } }
#pragma unroll
    for (int e = 0; e < 8; ++e) lg[e] = wave_sum(lg[e]);
}
__device__ __forceinline__ void router_pick(const float (&lg)[8], int& e0, int& e1, float& w0, float& w1) {
    e0 = 0; float l0 = lg[0];
#pragma unroll
    for (int e = 1; e < 8; ++e) if (lg[e] > l0) { l0 = lg[e]; e0 = e; }
    e1 = -1; float l1 = 0.f;
#pragma unroll
    for (int e = 0; e < 8; ++e) if (e != e0 && (e1 < 0 || lg[e] > l1)) { l1 = lg[e]; e1 = e; }
    const float ex = __expf(l1 - l0); w0 = 1.0f / (1.0f + ex); w1 = ex * w0;
}
__device__ __forceinline__ void router_phase(Frame& F) {
    const int tid_ = opq(F.tid), lane_ = tid_ & 63;
    LAS float* Wr = (LAS float*)F.lds;
    LAS unsigned* cnt = (LAS unsigned*)(F.lds + 32768);
    __syncthreads();
    for (int i = tid_; i < D * NE; i += NWAVES * 64) Wr[(i & 7) * D + (i >> 3)] = F.in[13][i];
    if (tid_ < NE) cnt[tid_] = 0u;
    __syncthreads();
    const bf16* Hs = (const bf16*)(F.ws + WS_A0); const float* gain = F.in[12];
    int* e01 = (int*)(F.ws + WS_E01); f32x2* w01 = (f32x2*)(F.ws + WS_W01); float* rstd3 = (float*)(F.ws + WS_RSTD3);
    const int gw = F.vcu * NWAVES + F.wave, NGW = F.G * NWAVES, lane = lane_;
    f32x4 gg[4];
#pragma unroll
    for (int j = 0; j < 4; ++j) gg[j] = ((const GAS f32x4*)gain + lane)[64 * j];
    for (int m = 2 * gw; m < T; m += 2 * NGW) {
        const GAS v2u* xa = (const GAS v2u*)(Hs + (size_t)m * D) + lane; const GAS v2u* xb = xa + D / 4;
        f32x4 va[4], vb[4]; float sa = 0.f, sb = 0.f;
#pragma unroll
        for (int j = 0; j < 4; ++j) { const v2u ra_ = xa[64 * j], rb_ = xb[64 * j];
            va[j] = (f32x4){bflo(ra_.x), bfhi(ra_.x), bflo(ra_.y), bfhi(ra_.y)}; vb[j] = (f32x4){bflo(rb_.x), bfhi(rb_.x), bflo(rb_.y), bfhi(rb_.y)}; }
#pragma unroll
        for (int j = 0; j < 4; ++j) { sa += (va[j].x * va[j].x + va[j].y * va[j].y) + (va[j].z * va[j].z + va[j].w * va[j].w); sb += (vb[j].x * vb[j].x + vb[j].y * vb[j].y) + (vb[j].z * vb[j].z + vb[j].w * vb[j].w); }
        const float ra = 1.0f / sqrtf(wave_sum(sa) * (1.f / D) + EPS), rb = 1.0f / sqrtf(wave_sum(sb) * (1.f / D) + EPS);
        { GAS unsigned* qa = (GAS unsigned*)(F.ws + WS_A8 + (size_t)m * D) + lane; GAS unsigned* qb = qa + D / 4;
#pragma unroll
          for (int j = 0; j < 4; ++j) { qa[64 * j] = pg8::pk4_fp8(va[j].x, va[j].y, va[j].z, va[j].w); qb[64 * j] = pg8::pk4_fp8(vb[j].x, vb[j].y, vb[j].z, vb[j].w); } }
        float la[8], lb[8];
        router_row(va, gg, ra, Wr, lane, la); router_row(vb, gg, rb, Wr, lane, lb);
        int a0, a1, b0, b1; float wa0, wa1, wb0, wb1;
        router_pick(la, a0, a1, wa0, wa1); router_pick(lb, b0, b1, wb0, wb1);
        if (lane == 0) { e01[m] = a0 | (a1 << 8); w01[m] = (f32x2){wa0, wa1}; rstd3[m] = ra; e01[m + 1] = b0 | (b1 << 8); w01[m + 1] = (f32x2){wb0, wb1}; rstd3[m + 1] = rb;
            atomicAdd((unsigned*)&cnt[a0], 1u); atomicAdd((unsigned*)&cnt[a1], 1u); atomicAdd((unsigned*)&cnt[b0], 1u); atomicAdd((unsigned*)&cnt[b1], 1u); }
    }
    __syncthreads();
    if (tid_ < NE) __hip_atomic_fetch_add(F.ctl + CW_MOE + 64 * tid_, cnt[tid_], __ATOMIC_RELAXED, __HIP_MEMORY_SCOPE_AGENT);
}
struct MoeOff { int o[9]; };
__device__ __forceinline__ void moe_offsets(Frame& F, int (&off)[9]) {
    off[0] = 0;
#pragma unroll
    for (int e = 0; e < 8; ++e) { const unsigned c = __hip_atomic_load(F.ctl + CW_MOE + 64 * e, __ATOMIC_RELAXED, __HIP_MEMORY_SCOPE_AGENT); off[e + 1] = off[e] + (int)((c + 255u) & ~255u); }
}
__device__ __forceinline__ void positions_phase(Frame& F) {
    const int tid_ = opq(F.tid), lane_ = tid_ & 63;
    int off[9]; moe_offsets(F, off);
    const int* e01 = (const int*)(F.ws + WS_E01); const f32x2* w01 = (const f32x2*)(F.ws + WS_W01);
    int* pos = (int*)(F.ws + WS_POS); int* idx = (int*)(F.ws + WS_IDX); float* gwt = (float*)(F.ws + WS_GW); float* prs = (float*)(F.ws + WS_PRS); const float* rstd3 = (const float*)(F.ws + WS_RSTD3);
    const int gw = F.vcu * NWAVES + F.wave, NGW = F.G * NWAVES, lane = lane_;
    const unsigned long long ltmask = (1ull << lane) - 1ull;
    for (int it = gw; it < T / 64; it += NGW) {
        const int t = it * 64 + lane; const int ee = e01[t]; const int e0 = ee & 0xff, e1 = ee >> 8; const f32x2 ww = w01[t];
        int p0 = 0, p1 = 0;
#pragma unroll
        for (int e = 0; e < 8; ++e) {
            const unsigned long long m0 = __ballot(e0 == e), m1 = __ballot(e1 == e);
            const int c0 = __popcll(m0), c1 = __popcll(m1);
            unsigned basev = 0u;
            if (lane == 0 && (c0 + c1) > 0) basev = __hip_atomic_fetch_add(F.ctl + CW_MOE + 64 * (8 + e), (unsigned)(c0 + c1), __ATOMIC_RELAXED, __HIP_MEMORY_SCOPE_AGENT);
            const int base = (int)__builtin_amdgcn_readfirstlane(basev) + off[e];
            if (e0 == e) p0 = base + __popcll(m0 & ltmask);
            if (e1 == e) p1 = base + c0 + __popcll(m1 & ltmask);
        }
        const float rs = rstd3[t];
        idx[p0] = t; gwt[p0] = ww.x; prs[p0] = rs; idx[p1] = t; gwt[p1] = ww.y; prs[p1] = rs;
        ((v2u*)pos)[t] = (v2u){(unsigned)p0, (unsigned)p1};
    }
    if (blockIdx.x < NE) {
        const int e = blockIdx.x; const int c = (int)__hip_atomic_load(F.ctl + CW_MOE + 64 * e, __ATOMIC_RELAXED, __HIP_MEMORY_SCOPE_AGENT);
        for (int p = off[e] + c + tid_; p < off[e + 1]; p += NWAVES * 64) { idx[p] = 0; gwt[p] = 0.f; prs[p] = 0.f; }
    }
}
__device__ __forceinline__ float f8tof(unsigned w, int i) { return i == 0 ? __builtin_amdgcn_cvt_f32_fp8((int)w, 0) : i == 1 ? __builtin_amdgcn_cvt_f32_fp8((int)w, 1) : i == 2 ? __builtin_amdgcn_cvt_f32_fp8((int)w, 2) : __builtin_amdgcn_cvt_f32_fp8((int)w, 3); }
__device__ __forceinline__ void final_phase(Frame& F) {
    const int tid_ = opq(F.tid), lane_ = tid_ & 63;
    const unsigned char* Yp = F.ws + WS_YP; const v2u* pos = (const v2u*)(F.ws + WS_POS); const f32x2* w01 = (const f32x2*)(F.ws + WS_W01); const float* gain = F.in[17];
    const int gw = F.vcu * NWAVES + F.wave, NGW = F.G * NWAVES, lane = lane_;
    f32x4 gg[4];
#pragma unroll
    for (int j = 0; j < 4; ++j) gg[j] = ((const GAS f32x4*)gain + lane)[64 * j];
    for (int m = 2 * gw; m < T; m += 2 * NGW) {
        f32x4 v[2][4]; unsigned ya[2][4], yb[2][4]; f32x2 ww[2];
#pragma unroll
        for (int q = 0; q < 2; ++q) { const v2u pp = pos[m + q]; ww[q] = w01[m + q];
            const GAS v2u* xr = (const GAS v2u*)((const bf16*)(F.ws + WS_A0) + (size_t)(m + q) * D) + lane;
            const GAS unsigned* y0 = (const GAS unsigned*)(Yp + (size_t)pp.x * D) + lane; const GAS unsigned* y1 = (const GAS unsigned*)(Yp + (size_t)pp.y * D) + lane;
#pragma unroll
            for (int j = 0; j < 4; ++j) { const v2u hx = xr[64 * j]; v[q][j] = (f32x4){bflo(hx.x), bfhi(hx.x), bflo(hx.y), bfhi(hx.y)}; ya[q][j] = y0[64 * j]; yb[q][j] = y1[64 * j]; } }
#pragma unroll
        for (int q = 0; q < 2; ++q) { float s = 0.f; const float wa = ww[q].x * (1.0f / Y8_SCALE), wb = ww[q].y * (1.0f / Y8_SCALE);
#pragma unroll
            for (int j = 0; j < 4; ++j) { const unsigned a = ya[q][j], b = yb[q][j];
                v[q][j].x += f8tof(a, 0) * wa + f8tof(b, 0) * wb; v[q][j].y += f8tof(a, 1) * wa + f8tof(b, 1) * wb; v[q][j].z += f8tof(a, 2) * wa + f8tof(b, 2) * wb; v[q][j].w += f8tof(a, 3) * wa + f8tof(b, 3) * wb;
                s += (v[q][j].x * v[q][j].x + v[q][j].y * v[q][j].y) + (v[q][j].z * v[q][j].z + v[q][j].w * v[q][j].w); }
            const float rstd = 1.0f / sqrtf(wave_sum(s) * (1.f / D) + EPS);
            GAS f32x4* xw = (GAS f32x4*)(F.out + (size_t)(m + q) * D) + lane;
#pragma unroll
            for (int j = 0; j < 4; ++j) { f32x4 y; y.x = v[q][j].x * rstd * gg[j].x; y.y = v[q][j].y * rstd * gg[j].y; y.z = v[q][j].z * rstd * gg[j].z; y.w = v[q][j].w * rstd * gg[j].w; xw[64 * j] = y; } }
    }
}

struct Args { const float* in[18]; float* out; unsigned char* ws; int ph_lo, ph_hi, li, pad; };
__global__ void __launch_bounds__(NWAVES * 64, 2) fwd_kernel(Args args) {
    extern __shared__ __attribute__((aligned(16))) unsigned char lds[];
    Frame F;
    F.lds = (LAS unsigned char*)lds;
    F.tid = threadIdx.x; F.lane = F.tid & 63; F.wave = __builtin_amdgcn_readfirstlane(F.tid >> 6);
    F.G = gridDim.x; { const int bx = blockIdx.x; F.vcu = (F.G % 8 == 0) ? (bx % 8) * (F.G / 8) + bx / 8 : bx; }
    unsigned char* ws = args.ws; F.ws = ws; F.out = args.out;
    F.ctl = (unsigned*)(ws + WS_CTL);
#pragma unroll
    for (int i = 0; i < 18; ++i) F.in[i] = args.in[i];
    volatile LAS unsigned* MISC = (volatile LAS unsigned*)(F.lds + MISC_OFF);
    for (int u = F.tid; u < (LDS_BYTES - RING_BYTES) / 4; u += NWAVES * 64) ((LAS unsigned*)(F.lds + RING_BYTES))[u] = 0u;
    __syncthreads();
    XcdBarrier bar = xcd_barrier_post(F.ctl + CW_BAR + args.li * XCD_BAR_WORDS, MISC + 8);
    LAS unsigned char* ring = F.lds;
#define GRID_BAR() xcd_barrier(bar)
    unsigned long long* ssq1 = (unsigned long long*)(ws + WS_SSQ1); unsigned long long* ssq2 = (unsigned long long*)(ws + WS_SSQ2);
    p0_prologue(F);
#if defined(PROBE_P0) || defined(PROBE_PASSES)
    GRID_BAR(); p0_prologue(F);
#endif
    GRID_BAR();
    {
        unsigned* barw = F.ctl + CW_BAR + args.li * XCD_BAR_WORDS; unsigned pre = 0u;
#pragma unroll
        for (unsigned j = 0; j < 16; ++j) { const unsigned c = xb_ld(&barw[XB_XCNT(j)]); pre += (j < bar.x) ? c : 0u; }
        F.vcu2 = __builtin_amdgcn_readfirstlane((int)(pre + MISC[10])); }
    {   pg8::Gemm g{(const bf16*)(ws + WS_A0), (const bf16*)(ws + WS_WRIN), 1024, nullptr, nullptr}; pg8::StaticOrder S; S.init(T / 256, 24, F.G, (int)blockIdx.x);
        pg8::EpiRetIn E{(bf16*)(ws + WS_A1), (bf16*)(ws + WS_A2), (bf16*)(ws + WS_A3), (bf16*)F.out, (const float*)(ws + WS_ROPE)};
        pg8::gemm_phase(ring, g, S, E); }
    GRID_BAR();
#ifdef PROBE_SCAN
    ret_scan_phase3<false, true>(F); GRID_BAR(); ret_scan_phase3<false, true>(F); GRID_BAR(); ret_scan_phase3<false, true>(F); GRID_BAR();
#endif
    ret_scan_phase3<false>(F);
    GRID_BAR();
    {   pg8::Gemm g{(const bf16*)F.out, (const bf16*)(ws + WS_WROUT), 2048, nullptr, (const unsigned long long*)(ws + WS_SSQH), true};     pg8::StaticOrder S; S.init(T / 256, 4, F.G, (int)blockIdx.x);
        pg8::EpiResNorm<false, false> E{F.in[0], nullptr, nullptr, (bf16*)(ws + WS_A0), ssq1, D, 1.0f};
        pg8::gemm_phase<pg8::EpiResNorm<false, false>, pg8::StaticOrder, false, true>(ring, g, S, E); }
    GRID_BAR();
    {   pg8::Gemm g{(const bf16*)(ws + WS_A0), (const bf16*)(ws + WS_WFGU), 1024, nullptr, nullptr}; pg8::StaticOrder S; S.init(T / 256, 28, F.G, (int)blockIdx.x);
        pg8::EpiSwiglu E{(bf16*)(ws + WS_A1), FF, ssq1, nullptr, -1, {{0.f, 0.f, 0.f, 0.f}, {0.f, 0.f, 0.f, 0.f}}, FFN8 ? ws + WS_A1 : nullptr, H8_SCALE};
        pg8::gemm_phase(ring, g, S, E);
#if defined(PROBE_P7X2) || defined(PROBE_G3)
        GRID_BAR(); pg8::gemm_phase(ring, g, S, E);
#endif
    }
    GRID_BAR();
    {   pg8::Gemm g{(const bf16*)(ws + WS_A1), (const bf16*)(ws + WS_WFD), FF, nullptr, nullptr, FFN8}; pg8::StaticOrder S; S.init(T / 256, 4, F.G, (int)blockIdx.x);
        pg8::EpiResNorm<true, false> E{nullptr, (const bf16*)(ws + WS_A0), nullptr, (bf16*)(ws + WS_A0), ssq2, D, FFN8 ? 1.0f / (W8_SCALE * H8_SCALE) : 1.0f};
        if constexpr (FFN8) pg8::gemm_phase<pg8::EpiResNorm<true, false>, pg8::StaticOrder, true>(ring, g, S, E); else pg8::gemm_phase(ring, g, S, E); }
    GRID_BAR();
    {   pg8::Gemm g{(const bf16*)(ws + WS_A0), (const bf16*)(ws + WS_WCIN), 1024, nullptr, nullptr}; pg8::StaticOrder S; S.init(T / 256, 12, F.G, (int)blockIdx.x);
        pg8::EpiConvIn E{(bf16*)(ws + WS_A1), (bf16*)(ws + WS_A2), ssq2, -1, {{0.f, 0.f, 0.f, 0.f}, {0.f, 0.f, 0.f, 0.f}}};
        pg8::gemm_phase(ring, g, S, E);
#ifdef PROBE_G3
        GRID_BAR(); pg8::gemm_phase(ring, g, S, E);
#endif
    }
    GRID_BAR();
    conv_phase(F);
#ifdef PROBE_PASSES
    GRID_BAR(); conv_phase(F);
#endif
    GRID_BAR();
    {   pg8::Gemm g{(const bf16*)(ws + WS_A4), (const bf16*)(ws + WS_WCOUT), 1024, nullptr, nullptr}; pg8::StaticOrder S; S.init(T / 256, 4, F.G, (int)blockIdx.x);
        pg8::EpiResNorm<true, false> E{nullptr, (const bf16*)(ws + WS_A0), nullptr, (bf16*)(ws + WS_A0), nullptr, D, 1.0f};
        pg8::gemm_phase(ring, g, S, E); }
    GRID_BAR();
    router_phase(F);
    GRID_BAR();
    positions_phase(F);
    GRID_BAR();
#ifdef PROBE_MOEX2
    for (int rep = 0; rep < 2; ++rep)
#endif
    {   int off[9]; moe_offsets(F, off);
        const int NT = off[8] >> 8;
#pragma unroll 1
        for (int sl = 0; sl < 1; ++sl) {
            const int t0 = 0, nm = NT;
            if (nm > 0 && nm <= HM_TILES) {
                { pg8::Gemm g{(const bf16*)(ws + WS_A8), (const bf16*)(ws + WS_WMGU), 1024, (const int*)(ws + WS_IDX), nullptr};
                  pg8::MoeOrder S; S.base.init(nm, 28, F.G, (int)blockIdx.x); S.t0 = t0; S.ntile_e = 28; S.a_local = false;
                  S.o1 = off[1] >> 8; S.o2 = off[2] >> 8; S.o3 = off[3] >> 8; S.o4 = off[4] >> 8; S.o5 = off[5] >> 8; S.o6 = off[6] >> 8; S.o7 = off[7] >> 8;
                  pg8::EpiSwiglu8 E{ws + WS_HM, FF, (const float*)(ws + WS_PRS), 1.0f / W8_SCALE, H8_SCALE, -1, {{0.f, 0.f, 0.f, 0.f}, {0.f, 0.f, 0.f, 0.f}}};
                  pg8::gemm_phase<pg8::EpiSwiglu8, pg8::MoeOrder, true>(ring, g, S, E); }
                GRID_BAR();
                { pg8::Gemm g{(const bf16*)(ws + WS_HM), (const bf16*)(ws + WS_WMD), FF, nullptr, nullptr, true};
                  pg8::MoeOrder S; S.base.init(nm, 4, F.G, (int)blockIdx.x); S.t0 = t0; S.ntile_e = 4; S.a_local = true;
                  S.o1 = off[1] >> 8; S.o2 = off[2] >> 8; S.o3 = off[3] >> 8; S.o4 = off[4] >> 8; S.o5 = off[5] >> 8; S.o6 = off[6] >> 8; S.o7 = off[7] >> 8;
                  pg8::EpiScaleF8 E{ws + WS_YP, D, Y8_SCALE / (W8_SCALE * H8_SCALE)};
                  pg8::gemm_phase<pg8::EpiScaleF8, pg8::MoeOrder, true>(ring, g, S, E); }
                GRID_BAR();
            }
        }
    }
#ifdef PROBE_BARS
    for (int rep = 0; rep < 10; ++rep) GRID_BAR();
#endif
    final_phase(F);
#ifdef PROBE_PASSES
    GRID_BAR(); final_phase(F);
#endif
}

extern "C" void kernel_launch(void* const* d_in, const int* in_sizes, int n_in, void* d_out, int out_size, void* d_ws, size_t ws_size, hipStream_t stream) {
    static int grid = 0;
    if (grid == 0) {
        if (n_in != 18 || in_sizes[0] != T * D || out_size != T * D || ws_size < WS_END) { fprintf(stderr, "kernel_launch: unexpected shapes (n_in %d, ws %zu)\n", n_in, ws_size); grid = -1; return; }
        int dev = 0, cus = 0, per_cu = 0;
        if (hipGetDevice(&dev) != hipSuccess || hipDeviceGetAttribute(&cus, hipDeviceAttributeMultiprocessorCount, dev) != hipSuccess) { grid = -1; return; }
        if (hipFuncSetAttribute((const void*)fwd_kernel, hipFuncAttributeMaxDynamicSharedMemorySize, LDS_BYTES) != hipSuccess) { grid = -1; return; }
        if (hipOccupancyMaxActiveBlocksPerMultiprocessor(&per_cu, (const void*)fwd_kernel, NWAVES * 64, LDS_BYTES) != hipSuccess || per_cu < 1) { fprintf(stderr, "kernel_launch: occupancy query says %d\n", per_cu); }
        (void)hipGetLastError();
        grid = cus;
    }
    if (grid < 0) return;
    if (hipMemsetAsync((char*)d_ws + WS_CTL, 0, CTL_ZERO_BYTES, stream) != hipSuccess) return;
    Args a{};
    for (int i = 0; i < 18; ++i) a.in[i] = (const float*)d_in[i];
    a.out = (float*)d_out; a.ws = (unsigned char*)d_ws; a.pad = 0;
    a.ph_lo = 0; a.ph_hi = NPH; a.li = 0;
    hipLaunchKernelGGL(fwd_kernel, dim3(grid), dim3(NWAVES * 64), LDS_BYTES, stream, a);
}
```

```cpp
#include <hip/hip_runtime.h>
#include <cstdio>
#include <cstdint>

#ifndef MK_BAL
#define MK_BAL 1
#endif
namespace pg8 {
#define PG8_LAS __attribute__((address_space(3)))
typedef unsigned short bf16_t;
typedef short bf16x8 __attribute__((ext_vector_type(8)));
typedef float f32x4 __attribute__((ext_vector_type(4)));
typedef float f32x2 __attribute__((ext_vector_type(2)));
typedef unsigned u32x4 __attribute__((ext_vector_type(4)));
typedef unsigned u32x2 __attribute__((ext_vector_type(2)));
constexpr int BM = 256, BK = 64, HALF = 128, HTB = HALF * BK * 2, STAGE_BYTES = 8 * HTB, NXCD = 8, WGM = 8;

__host__ __device__ __forceinline__ int lds_byte(int r, int c) { const int st = (r >> 4) * 2 + (c >> 5), rr = r & 15, cc = c & 31, ob = rr * 64 + cc * 2; return st * 1024 + (ob ^ (((ob >> 9) & 1) << 5)); }
__host__ __device__ __forceinline__ void stage_rc(int b, int& R, int& C) { const int st = b / 1024, sb = b % 1024, swz = sb ^ (((sb >> 9) & 1) << 5); R = (st >> 1) * 16 + swz / 64; C = (st & 1) * 32 + (swz % 64) / 2; }
__host__ __device__ __forceinline__ int lds_byteB(int r, int cb) { const int st = (r >> 4) * 2 + (cb >> 6), ob0 = (r & 15) * 64 + (cb & 63); return st * 1024 + (ob0 ^ (((ob0 >> 9) & 1) << 5)); }
typedef int v8i __attribute__((ext_vector_type(8)));
typedef int v4i __attribute__((ext_vector_type(4)));
__host__ __device__ __forceinline__ int perm32(int rho) { const int n = rho >> 4, i = rho & 15; return 8 * (i >> 2) + 4 * n + (i & 3); }

struct Unit { int pm, pn, pmo, pno; };
struct Gemm { const bf16_t* A; const bf16_t* Bt; int K; const int* gidx; const unsigned long long* hss; bool aimg = false; };

struct StaticOrder {
    int nM, nN, nwg, G, c;
    __host__ __device__ void init(int nM_, int nN_, int G_, int c_) { nM = nM_; nN = nN_; nwg = nM * nN; G = G_; c = c_; }
    __host__ __device__ bool next(int i, Unit& u) const {
        const long L = (long)i * G + c; if (L >= nwg) return false;
        int wgid = (int)L; { const int q = nwg / NXCD, r = nwg % NXCD, xcd = wgid % NXCD, off = wgid / NXCD; wgid = (xcd < r ? xcd * (q + 1) : r * (q + 1) + (xcd - r) * q) + off; }
        const int nig = WGM * nN, gid = wgid / nig, fm = gid * WGM, gsz = (nM - fm) < WGM ? (nM - fm) : WGM;
        u.pm = fm + ((wgid % nig) % gsz); u.pn = (wgid % nig) / gsz; u.pmo = u.pm; u.pno = u.pn; return true;
    }
};
struct MoeOrder {
    StaticOrder base; int t0, ntile_e; int o1, o2, o3, o4, o5, o6, o7; bool a_local;
    __device__ bool next(int i, Unit& u) const {
        if (!base.next(i, u)) return false;
        const int l = u.pm, t = t0 + l;
        const int e = (t >= o1) + (t >= o2) + (t >= o3) + (t >= o4) + (t >= o5) + (t >= o6) + (t >= o7);
        u.pno = u.pn; u.pn = e * ntile_e + u.pn;
        if (a_local) { u.pm = l; u.pmo = t; } else { u.pm = t; u.pmo = l; }
        return true;
    }
};

__device__ __forceinline__ int opq_i(int v) { asm volatile("" : "+v"(v)); return v; }
__device__ __forceinline__ unsigned cvt_pk_bf16(float lo, float hi) { unsigned r; asm volatile("v_cvt_pk_bf16_f32 %0, %1, %2" : "=v"(r) : "v"(lo), "v"(hi)); return r; }
__device__ __forceinline__ unsigned pk4_fp8(float a, float b, float c, float d) { int w = 0; w = __builtin_amdgcn_cvt_pk_fp8_f32(a, b, w, false); w = __builtin_amdgcn_cvt_pk_fp8_f32(c, d, w, true); return (unsigned)w; }
__device__ __forceinline__ float silu_f(float v) { return v * __builtin_amdgcn_rcpf(1.0f + __expf(-v)); }
__device__ __forceinline__ u32x4 widen16(u32x2 X, u32x2 Y) {
    const auto r0 = __builtin_amdgcn_permlane16_swap(X.x, Y.x, false, false); const auto r1 = __builtin_amdgcn_permlane16_swap(X.y, Y.y, false, false);
    return (u32x4){r0[0], r1[0], r0[1], r1[1]};
}
__device__ __forceinline__ void swiglu8(const f32x4 g0, const f32x4 g1, const f32x4 u0, const f32x4 u1, float rs, float post, f32x4& h0, f32x4& h1) {
    const float nl = rs * -1.44269504f, k = __builtin_amdgcn_rcpf(rs * rs * post);
    f32x4 e0 = g0 * nl, e1 = g1 * nl;
#pragma unroll
    for (int x = 0; x < 4; ++x) { e0[x] = __builtin_amdgcn_exp2f(e0[x]); e1[x] = __builtin_amdgcn_exp2f(e1[x]); }
    f32x4 d0 = e0 * k + k, d1 = e1 * k + k;
#pragma unroll
    for (int x = 0; x < 4; ++x) { d0[x] = __builtin_amdgcn_rcpf(d0[x]); d1[x] = __builtin_amdgcn_rcpf(d1[x]); }
    h0 = g0 * u0 * d0; h1 = g1 * u1 * d1;
}

struct EpiSwiglu {
    static constexpr bool PERM = true;
    bf16_t* O; int ldc; const unsigned long long* ssq; const float* rsd;
    int last_pm; float rsc[2][4];
    unsigned char* O8; float post8;
    __device__ __forceinline__ void operator()(const f32x4 (&acc)[2][2][4][2], const Unit& u, int wr, int wc, int fr, int fq) {
        const int row0 = u.pmo * BM + wr * 64 + fr; const int col0 = u.pno * HALF + wc * 32 + 8 * fq; const int rsr0 = u.pm * BM + wr * 64 + fr;
        if (u.pm != last_pm) { last_pm = u.pm;
#pragma unroll
            for (int ai = 0; ai < 2; ++ai)
#pragma unroll
                for (int m = 0; m < 4; ++m) rsc[ai][m] = ssq ? __builtin_amdgcn_rsqf((float)ssq[rsr0 + ai * HALF + m * 16] * (1.0f / (1024.0f * 4294967296.0f)) + 1e-6f) : rsd[rsr0 + ai * HALF + m * 16]; }
        if (O8) {
#pragma unroll
            for (int ai = 0; ai < 2; ++ai)
#pragma unroll
                for (int mp = 0; mp < 2; ++mp) { u32x2 w8[2];
#pragma unroll
                    for (int j = 0; j < 2; ++j) { const int m = 2 * mp + j; f32x4 h0, h1; swiglu8(acc[ai][0][m][0], acc[ai][0][m][1], acc[ai][1][m][0], acc[ai][1][m][1], rsc[ai][m], post8, h0, h1);
                        w8[j].x = pk4_fp8(h0[0], h0[1], h0[2], h0[3]); w8[j].y = pk4_fp8(h1[0], h1[1], h1[2], h1[3]); }
                    const int r = row0 + ai * HALF + (2 * mp + (fq & 1)) * 16;
                    *(u32x4*)(O8 + ((size_t)(r >> 7) * (ldc / HALF) + u.pno) * HTB + (((r & 127) >> 4) * 2 + (wc >> 1)) * 1024 + (((fr * 64 + 32 * (wc & 1) + 8 * (fq & 2))) ^ ((fr >> 3) << 5))) = widen16(w8[0], w8[1]); }
        } else {
#pragma unroll
        for (int ai = 0; ai < 2; ++ai)
#pragma unroll
            for (int m = 0; m < 4; ++m) { const int r = row0 + ai * HALF + m * 16; bf16_t* rowp = O + (size_t)r * ldc + col0;
                const float rs = rsc[ai][m];
                f32x4 h0, h1; swiglu8(acc[ai][0][m][0], acc[ai][0][m][1], acc[ai][1][m][0], acc[ai][1][m][1], rs, 1.0f, h0, h1);
                u32x4 w; w.x = cvt_pk_bf16(h0[0], h0[1]); w.y = cvt_pk_bf16(h0[2], h0[3]); w.z = cvt_pk_bf16(h1[0], h1[1]); w.w = cvt_pk_bf16(h1[2], h1[3]);
                *(u32x4*)rowp = w; } }
    }
};
struct EpiConvIn {
    static constexpr bool PERM = true;
    bf16_t* Bc; bf16_t* U; const unsigned long long* ssq;
    int last_pm; float rsc[2][4];
    __device__ __forceinline__ void operator()(const f32x4 (&acc)[2][2][4][2], const Unit& u, int wr, int wc, int fr, int fq) {
        const int row0 = u.pmo * BM + wr * 64 + fr;
        if (u.pmo != last_pm) { last_pm = u.pmo;
#pragma unroll
            for (int ai = 0; ai < 2; ++ai)
#pragma unroll
                for (int m = 0; m < 4; ++m) rsc[ai][m] = __builtin_amdgcn_rsqf((float)ssq[row0 + ai * HALF + m * 16] * (1.0f / (1024.0f * 4294967296.0f)) + 1e-6f); }
        if (u.pno < 4) {
            const int col0 = u.pno * BM + wc * 32 + 8 * fq;
#pragma unroll
            for (int ai = 0; ai < 2; ++ai)
#pragma unroll
                for (int m = 0; m < 4; ++m) { bf16_t* rowp = Bc + (size_t)(row0 + ai * HALF + m * 16) * 1024 + col0; const float rs = rsc[ai][m];
#pragma unroll
                    for (int bj = 0; bj < 2; ++bj) { const f32x4 v0 = acc[ai][bj][m][0] * rs, v1 = acc[ai][bj][m][1] * rs;
                        u32x4 w; w.x = cvt_pk_bf16(v0[0], v0[1]); w.y = cvt_pk_bf16(v0[2], v0[3]); w.z = cvt_pk_bf16(v1[0], v1[1]); w.w = cvt_pk_bf16(v1[2], v1[3]);
                        *(u32x4*)(rowp + bj * HALF) = w; } }
        } else {
            const int col0 = (u.pno - 4) * HALF + wc * 32 + 8 * fq;
#pragma unroll
            for (int ai = 0; ai < 2; ++ai)
#pragma unroll
                for (int m = 0; m < 4; ++m) { bf16_t* rowp = U + (size_t)(row0 + ai * HALF + m * 16) * 1024 + col0; const float rs2 = rsc[ai][m] * rsc[ai][m];
                    const f32x4 v0 = acc[ai][0][m][0] * acc[ai][1][m][0] * rs2, v1 = acc[ai][0][m][1] * acc[ai][1][m][1] * rs2;
                    u32x4 w; w.x = cvt_pk_bf16(v0[0], v0[1]); w.y = cvt_pk_bf16(v0[2], v0[3]); w.z = cvt_pk_bf16(v1[0], v1[1]); w.w = cvt_pk_bf16(v1[2], v1[3]);
                    *(u32x4*)rowp = w; }
        }
    }
};
struct EpiSwiglu8 {
    static constexpr bool PERM = true;
    unsigned char* O; int ldc; const float* rsd; float pre, post;
    int last_pm; float rsc[2][4];
    __device__ __forceinline__ void operator()(const f32x4 (&acc)[2][2][4][2], const Unit& u, int wr, int wc, int fr_, int fq_) {
        const int fr = opq_i(fr_), fq = opq_i(fq_);
        const int row0 = u.pmo * BM + wr * 64 + fr; const int col0 = u.pno * HALF + wc * 32 + 8 * fq; const int rsr0 = u.pm * BM + wr * 64 + fr;
        if (u.pm != last_pm) { last_pm = u.pm;
#pragma unroll
            for (int ai = 0; ai < 2; ++ai)
#pragma unroll
                for (int m = 0; m < 4; ++m) rsc[ai][m] = rsd[rsr0 + ai * HALF + m * 16] * pre; }
#pragma unroll
        for (int ai = 0; ai < 2; ++ai)
#pragma unroll
            for (int mp = 0; mp < 2; ++mp) { u32x2 w8[2];
#pragma unroll
                for (int j = 0; j < 2; ++j) { const int m = 2 * mp + j; f32x4 h0, h1; swiglu8(acc[ai][0][m][0], acc[ai][0][m][1], acc[ai][1][m][0], acc[ai][1][m][1], rsc[ai][m], post, h0, h1);
                    w8[j].x = pk4_fp8(h0[0], h0[1], h0[2], h0[3]); w8[j].y = pk4_fp8(h1[0], h1[1], h1[2], h1[3]); }
                const int r = row0 + ai * HALF + (2 * mp + (fq & 1)) * 16;
                *(u32x4*)(O + ((size_t)(r >> 7) * (ldc / HALF) + u.pno) * HTB + (((r & 127) >> 4) * 2 + (wc >> 1)) * 1024 + (((fr * 64 + 32 * (wc & 1) + 8 * (fq & 2))) ^ ((fr >> 3) << 5))) = widen16(w8[0], w8[1]); }
    }
};
struct EpiScaleF8 {
    static constexpr bool PERM = true;
    unsigned char* O; int ldc; float sc;
    __device__ __forceinline__ void operator()(const f32x4 (&acc)[2][2][4][2], const Unit& u, int wr, int wc, int fr_, int fq_) const {
        const int fr = opq_i(fr_), fq = opq_i(fq_);
        const int row0 = u.pmo * BM + wr * 64 + fr; const int col0 = u.pno * BM + wc * 32 + 8 * fq;
#pragma unroll
        for (int ai = 0; ai < 2; ++ai)
#pragma unroll
            for (int mp = 0; mp < 2; ++mp) { unsigned char* rowp = O + (size_t)(row0 + ai * HALF + (2 * mp + (fq & 1)) * 16) * ldc + col0 - 8 * (fq & 1);
#pragma unroll
                for (int bj = 0; bj < 2; ++bj) { u32x2 w8[2];
#pragma unroll
                    for (int j = 0; j < 2; ++j) { const f32x4 v0 = acc[ai][bj][2 * mp + j][0] * sc, v1 = acc[ai][bj][2 * mp + j][1] * sc;
                        w8[j].x = pk4_fp8(v0[0], v0[1], v0[2], v0[3]); w8[j].y = pk4_fp8(v1[0], v1[1], v1[2], v1[3]); }
                    *(u32x4*)(rowp + bj * HALF) = widen16(w8[0], w8[1]); } }
    }
};
struct EpiProbe {
    static constexpr bool PERM = true;
    bf16_t* O;
    __device__ __forceinline__ void operator()(const f32x4 (&acc)[2][2][4][2], const Unit& u, int wr, int wc, int fr, int fq) const {
        f32x4 s = (f32x4){0.f, 0.f, 0.f, 0.f};
#pragma unroll
        for (int ai = 0; ai < 2; ++ai)
#pragma unroll
            for (int m = 0; m < 4; ++m)
#pragma unroll
                for (int bj = 0; bj < 2; ++bj) s += acc[ai][bj][m][0] + acc[ai][bj][m][1];
        if (s[0] + s[1] + s[2] + s[3] == 1.2345e33f) O[u.pmo] = 1;
    }
};
template <bool BASE_BF16, bool OUT_F32> struct EpiResNorm {
    static constexpr bool PERM = true;
    const float* base_f; const bf16_t* base_b; float* out; bf16_t* hb; unsigned long long* ssq; int ldc; float accs;
    __device__ __forceinline__ void operator()(const f32x4 (&acc)[2][2][4][2], const Unit& u, int wr, int wc, int fr, int fq) const {
        const int row0 = u.pmo * BM + wr * 64 + fr, col0 = u.pno * BM + wc * 32 + 8 * fq;
#pragma unroll
        for (int ai = 0; ai < 2; ++ai) {
            f32x4 bf[4][2][2]; u32x4 bw[4][2];
#pragma unroll
            for (int m = 0; m < 4; ++m)
#pragma unroll
                for (int bj = 0; bj < 2; ++bj) { const size_t off = (size_t)(row0 + ai * HALF + m * 16) * ldc + col0 + bj * HALF;
                    if constexpr (BASE_BF16) bw[m][bj] = *(const u32x4*)(base_b + off);
                    else { bf[m][bj][0] = *(const f32x4*)(base_f + off); bf[m][bj][1] = *(const f32x4*)(base_f + off + 4); } }
            __builtin_amdgcn_sched_barrier(0);
            float ss[4];
#pragma unroll
            for (int m = 0; m < 4; ++m) { const size_t off = (size_t)(row0 + ai * HALF + m * 16) * ldc + col0; ss[m] = 0.f;
#pragma unroll
                for (int bj = 0; bj < 2; ++bj) { f32x4 b0, b1;
                    if constexpr (BASE_BF16) { const u32x4 w_ = bw[m][bj];
                        b0 = (f32x4){__builtin_bit_cast(float, w_.x << 16), __builtin_bit_cast(float, w_.x & 0xffff0000u), __builtin_bit_cast(float, w_.y << 16), __builtin_bit_cast(float, w_.y & 0xffff0000u)};
                        b1 = (f32x4){__builtin_bit_cast(float, w_.z << 16), __builtin_bit_cast(float, w_.z & 0xffff0000u), __builtin_bit_cast(float, w_.w << 16), __builtin_bit_cast(float, w_.w & 0xffff0000u)}; }
                    else { b0 = bf[m][bj][0]; b1 = bf[m][bj][1]; }
                    const f32x4 v0 = b0 + acc[ai][bj][m][0] * accs, v1 = b1 + acc[ai][bj][m][1] * accs;
                    if constexpr (OUT_F32) { *(f32x4*)(out + off + bj * HALF) = v0; *(f32x4*)(out + off + bj * HALF + 4) = v1; }
                    if (hb) { u32x4 w; w.x = cvt_pk_bf16(v0[0], v0[1]); w.y = cvt_pk_bf16(v0[2], v0[3]); w.z = cvt_pk_bf16(v1[0], v1[1]); w.w = cvt_pk_bf16(v1[2], v1[3]);
                        *(u32x4*)(hb + off + bj * HALF) = w; }
                    ss[m] += (v0[0] * v0[0] + v0[1] * v0[1]) + (v0[2] * v0[2] + v0[3] * v0[3]) + (v1[0] * v1[0] + v1[1] * v1[1]) + (v1[2] * v1[2] + v1[3] * v1[3]); } }
            if (ssq) {
#pragma unroll
                for (int m = 0; m < 4; ++m) { ss[m] += __shfl_xor(ss[m], 16); ss[m] += __shfl_xor(ss[m], 32); }
                if (fq == 0) {
#pragma unroll
                    for (int m = 0; m < 4; ++m) __hip_atomic_fetch_add(ssq + row0 + ai * HALF + m * 16, (unsigned long long)(ss[m] * 4294967296.0f), __ATOMIC_RELAXED, __HIP_MEMORY_SCOPE_AGENT); } }
            asm volatile("" ::: "memory"); }
    }
};
struct EpiRetIn {
    static constexpr bool PERM = true;
    bf16_t *Q, *Kk, *V, *G; const float* invf;
    __device__ __forceinline__ void operator()(const f32x4 (&acc)[2][2][4][2], const Unit& u, int wr, int wc, int fr, int fq) const {
        const int row0 = u.pmo * BM + wr * 64 + fr, pn = u.pno;
        if (pn < 8) {
            const int h = pn & 3;
            const int lb = (fr * 64 + fq * 16) ^ ((fr >> 3) << 5);
            unsigned char* kdst = (unsigned char*)Kk + (size_t)(4 * h + (wc >> 1)) * HTB + (wc & 1) * 1024 + lb;
            bf16_t* qdst = Q + (size_t)h * 4096 + wc * 512 + (fq * 16 + fr) * 8;
            const float l2g = __log2f(1.0f - exp2f(-(float)(5 + h)));
            const float l2s = pn < 4 ? l2g : -l2g, scm = pn < 4 ? 1.0f : 0.0625f;
            const size_t d2 = pn < 4 ? (size_t)4096 : (size_t)(2 * HTB);
            const float* tbl = invf + (size_t)(wc * 4 * 64 + fq * 16 + fr) * 4;
            f32x4 tq[2][4];
#pragma unroll
            for (int q = 0; q < 4; ++q) tq[0][q] = *(const f32x4*)(tbl + (size_t)((row0 & 8191) >> 4) * 4096 + q * 256);
#pragma unroll
            for (int ai = 0; ai < 2; ++ai)
#pragma unroll
                for (int m = 0; m < 4; ++m) { const int r = row0 + ai * HALF + m * 16, ic = r & 127; constexpr int unused_ = 0; (void)unused_;
                    const int gi = ai * 4 + m;
                    if (gi < 7) { const int rn = row0 + ((gi + 1) >> 2) * HALF + ((gi + 1) & 3) * 16;
#pragma unroll
                        for (int q = 0; q < 4; ++q) tq[(gi + 1) & 1][q] = *(const f32x4*)(tbl + (size_t)((rn & 8191) >> 4) * 4096 + q * 256); }
                    const float sc = __builtin_amdgcn_exp2f((float)ic * l2s) * scm;
                    float cs[8], sn[8];
#pragma unroll
                    for (int j = 0; j < 4; ++j) { cs[j] = tq[gi & 1][0][j] * sc; cs[4 + j] = tq[gi & 1][1][j] * sc; sn[j] = tq[gi & 1][2][j] * sc; sn[4 + j] = tq[gi & 1][3][j] * sc; }
                    const f32x4 a0 = acc[ai][0][m][0], a1 = acc[ai][0][m][1], b0 = acc[ai][1][m][0], b1 = acc[ai][1][m][1];
                    f32x4 o10, o11, o20, o21;
#pragma unroll
                    for (int x = 0; x < 4; ++x) { o10[x] = a0[x] * cs[x] - b0[x] * sn[x]; o20[x] = a0[x] * sn[x] + b0[x] * cs[x];
                        o11[x] = a1[x] * cs[4 + x] - b1[x] * sn[4 + x]; o21[x] = a1[x] * sn[4 + x] + b1[x] * cs[4 + x]; }
                    u32x4 w1, w2; w1.x = cvt_pk_bf16(o10[0], o10[1]); w1.y = cvt_pk_bf16(o10[2], o10[3]); w1.z = cvt_pk_bf16(o11[0], o11[1]); w1.w = cvt_pk_bf16(o11[2], o11[3]);
                    w2.x = cvt_pk_bf16(o20[0], o20[1]); w2.y = cvt_pk_bf16(o20[2], o20[3]); w2.z = cvt_pk_bf16(o21[0], o21[1]); w2.w = cvt_pk_bf16(o21[2], o21[3]);
                    unsigned char* bp = pn < 4 ? (unsigned char*)(qdst + (size_t)(r >> 4) * 16384) : kdst + (size_t)(r >> 7) * (16 * HTB) + ((r & 127) >> 4) * 2048;
                    *(u32x4*)bp = w1; *(u32x4*)(bp + d2) = w2; }
        } else {
            const int lb = (fr * 64 + fq * 16) ^ ((fr >> 3) << 5);
            unsigned char* dst = (unsigned char*)(pn < 16 ? V : G) + (size_t)(((pn & 7) * 4) + (wc >> 1)) * HTB + (wc & 1) * 1024 + lb;
#pragma unroll
            for (int ai = 0; ai < 2; ++ai)
#pragma unroll
                for (int m = 0; m < 4; ++m) { const int r = row0 + ai * HALF + m * 16; unsigned char* rowp = dst + (size_t)(r >> 7) * (32 * HTB) + ((r & 127) >> 4) * 2048;
#pragma unroll
                    for (int bj = 0; bj < 2; ++bj) { const f32x4 v0 = acc[ai][bj][m][0], v1 = acc[ai][bj][m][1];
                        u32x4 w; w.x = cvt_pk_bf16(v0[0], v0[1]); w.y = cvt_pk_bf16(v0[2], v0[3]); w.z = cvt_pk_bf16(v1[0], v1[1]); w.w = cvt_pk_bf16(v1[2], v1[3]);
                        *(u32x4*)(rowp + bj * 2 * HTB) = w; } }
        }
    }
};

__device__ __forceinline__ void a_offsets(const int* gidx, int pm, int rowb, const int (&R)[2], const int (&C)[2], unsigned (&o)[2][2], bool aimg = false, int tid16 = 0) {
    if (aimg) {
#pragma unroll
        for (int h = 0; h < 2; ++h)
#pragma unroll
            for (int i = 0; i < 2; ++i) o[h][i] = (unsigned)(2 * pm + h) * (unsigned)(rowb / (2 * BK)) * (unsigned)HTB + (unsigned)(tid16 + i * 8192);
        return; }
#pragma unroll
    for (int h = 0; h < 2; ++h)
#pragma unroll
        for (int i = 0; i < 2; ++i) { const int rl = pm * BM + h * HALF + R[i]; const int row = gidx ? gidx[rl] : rl; o[h][i] = (unsigned)row * (unsigned)rowb + (unsigned)C[i] * 2u; }
}

template <class Epi, class Sched, bool F8 = false, bool HS = false>
__device__ __forceinline__ void gemm_phase(PG8_LAS unsigned char* lds, const Gemm g, const Sched& S, Epi& E) {
    int tid_ = threadIdx.x; asm volatile("" : "+v"(tid_));
    const int tid = tid_, wid = __builtin_amdgcn_readfirstlane(tid >> 6), lane = tid & 63, wr = wid >> 2, wc = wid & 3, fr = lane & 15, fq = lane >> 4;
    const int K = g.K, rowb = F8 ? K : 2 * K, nt = rowb / (2 * BK);
    int Rr[2], Cc[2]; unsigned voffB[2];
#pragma unroll
    for (int i = 0; i < 2; ++i) { int R, C; stage_rc(tid * 16 + i * 8192, R, C); Rr[i] = R; Cc[i] = C; voffB[i] = (unsigned)(tid * 16 + i * 8192); }
    static_assert(Epi::PERM, "the pre-tiled weight images are written in perm32 row order");
    const size_t kstep = g.aimg ? (size_t)HTB : (size_t)(BK * 2);
    const size_t kstepB = (size_t)HTB;
    const size_t hstep = (size_t)nt * HTB;
    const size_t tstep = 2 * hstep;
    const unsigned ldsw = (unsigned)wid * 1024u;
    const int aoff = lds_byte(wr * 64 + fr, fq * 8), boff = lds_byte(wc * 32 + fr, fq * 8);
#define PG8_SA(b, h) (((b) * 2 + (h)) * HTB)
#define PG8_SB(b, h) ((4 + (b) * 2 + (h)) * HTB)
#define PG8_STAGE(bufoff, gbase, voff) do { _Pragma("unroll") for (int _i = 0; _i < 2; ++_i) \
        __builtin_amdgcn_global_load_lds((const unsigned*)((const char*)(gbase) + (voff)[_i]), (PG8_LAS unsigned*)(lds + (bufoff) + ldsw + _i * 8192), 16, 0, 0); } while (0)
#define PG8_LD8(p) __builtin_shufflevector(*(const PG8_LAS v4i*)(p), *(const PG8_LAS v4i*)((p) + 1024), 0, 1, 2, 3, 4, 5, 6, 7)
#define PG8_LDA(dst, b, h) do { if constexpr (F8) { _Pragma("unroll") for (int m = 0; m < 4; ++m) dst##8[m] = PG8_LD8(lds + PG8_SA(b, h) + aoff + m * 2048); } \
        else { _Pragma("unroll") for (int m = 0; m < 4; ++m) _Pragma("unroll") for (int k = 0; k < 2; ++k) dst[m][k] = *(const PG8_LAS bf16x8*)(lds + PG8_SA(b, h) + aoff + m * 2048 + k * 1024); } } while (0)
#define PG8_LDB(dst, b, h) do { if constexpr (F8) { _Pragma("unroll") for (int n = 0; n < 2; ++n) dst##8[n] = PG8_LD8(lds + PG8_SB(b, h) + boff + n * 2048); } \
        else { _Pragma("unroll") for (int n = 0; n < 2; ++n) _Pragma("unroll") for (int k = 0; k < 2; ++k) dst[n][k] = *(const PG8_LAS bf16x8*)(lds + PG8_SB(b, h) + boff + n * 2048 + k * 1024); } } while (0)
#define PG8_MMA(ai, bj, At, Bt) do { __builtin_amdgcn_s_setprio(1); _Pragma("unroll") for (int m = 0; m < 4; ++m) _Pragma("unroll") for (int n = 0; n < 2; ++n) { \
        if constexpr (F8) asm volatile("v_mfma_scale_f32_16x16x128_f8f6f4 %0, %1, %2, %0, %3, %3 op_sel_hi:[0,0,0]" : "+v"(acc[ai][bj][m][n]) : "v"(Bt##8[n]), "v"(At##8[m]), "v"(one8)); \
        else { _Pragma("unroll") for (int k = 0; k < 2; ++k) acc[ai][bj][m][n] = __builtin_amdgcn_mfma_f32_16x16x32_bf16(Bt[n][k], At[m][k], acc[ai][bj][m][n], 0, 0, 0); } } __builtin_amdgcn_s_setprio(0); } while (0)
#define PG8_WAIT_V(n) asm volatile("s_waitcnt vmcnt(" #n ")" ::: "memory")
#define PG8_WAIT_L(n) asm volatile("s_waitcnt lgkmcnt(" #n ")" ::: "memory")
#define PG8_BAR __builtin_amdgcn_s_barrier()
#define PG8_SCHED __builtin_amdgcn_sched_barrier(0)
    Unit cur, nxt; int ui = 0;
    if (!S.next(0, cur)) return;
    f32x4 acc[2][2][4][2];
#pragma unroll
    for (int a = 0; a < 2; ++a)
#pragma unroll
        for (int b = 0; b < 2; ++b)
#pragma unroll
            for (int m = 0; m < 4; ++m)
#pragma unroll
                for (int n = 0; n < 2; ++n) acc[a][b][m][n] = (f32x4){0.f, 0.f, 0.f, 0.f};
    bf16x8 At[4][2], B0[2][2], B1[2][2]; v8i At8[4], B08[2], B18[2];
    const int one8 = 0x7f7f7f7f;
    unsigned offC[2][2], offN[2][2];
    a_offsets(g.gidx, cur.pm, rowb, Rr, Cc, offC, g.aimg, tid * 16);
    const char* const Ab = (const char*)g.A;
    const char* cB = (const char*)g.Bt + (size_t)cur.pn * tstep;
    PG8_STAGE(PG8_SB(0, 0), cB, voffB); PG8_STAGE(PG8_SB(0, 1), cB + hstep, voffB); PG8_STAGE(PG8_SA(0, 0), Ab, offC[0]); PG8_STAGE(PG8_SA(0, 1), Ab, offC[1]);
    if (wr == 1) PG8_BAR;
    PG8_WAIT_V(2); PG8_BAR;
    constexpr bool BAL = (MK_BAL != 0) && !F8;
    if constexpr (BAL) { PG8_STAGE(PG8_SB(1, 0), cB + kstepB, voffB); PG8_STAGE(PG8_SA(1, 0), Ab + kstep, offC[0]); PG8_WAIT_V(4); PG8_BAR; }
    else { PG8_STAGE(PG8_SB(1, 0), cB + kstepB, voffB); PG8_STAGE(PG8_SA(1, 0), Ab + kstep, offC[0]); PG8_STAGE(PG8_SB(1, 1), cB + hstep + kstepB, voffB);
    PG8_WAIT_V(6); PG8_BAR; }
    for (;;) {
        const bool has_next = S.next(ui + 1, nxt);
        if (has_next && !(g.gidx && nxt.pm == cur.pm)) a_offsets(g.gidx, nxt.pm, rowb, Rr, Cc, offN, g.aimg, tid * 16);
        else {
#pragma unroll
            for (int h = 0; h < 2; ++h)
#pragma unroll
                for (int i = 0; i < 2; ++i) offN[h][i] = offC[h][i]; }
        const char* nB = has_next ? (const char*)g.Bt + (size_t)nxt.pn * tstep : cB;
        PG8_LAS float* const hstab = (PG8_LAS float*)(lds + STAGE_BYTES + 1024 + (ui & 1) * 4096);
        if constexpr (HS) { if (tid < 256) { const u32x4* p = (const u32x4*)(g.hss + (size_t)(cur.pm * BM + tid) * 4); const u32x4 lo = p[0], hi = p[1];
            const float k = 1.0f / (512.0f * 4294967296.0f);
            const float r0 = __builtin_amdgcn_rsqf((float)(((unsigned long long)lo.y << 32) | lo.x) * k + 1e-6f), r1 = __builtin_amdgcn_rsqf((float)(((unsigned long long)lo.w << 32) | lo.z) * k + 1e-6f);
            const float r2 = __builtin_amdgcn_rsqf((float)(((unsigned long long)hi.y << 32) | hi.x) * k + 1e-6f), r3 = __builtin_amdgcn_rsqf((float)(((unsigned long long)hi.w << 32) | hi.z) * k + 1e-6f);
            *(PG8_LAS f32x4*)(hstab + tid * 4) = (f32x4){r0 / r1, r1 / r2, r2 / r3, r3}; } }
#pragma unroll 1
        for (int t = 0; t < nt; t += 2) {
            const bool last = (t == nt - 2);
            if constexpr (HS) { if (t == 8 || t == 16 || t == 24) { const int hq = (t >> 3) - 1;
#pragma unroll
                for (int ai = 0; ai < 2; ++ai)
#pragma unroll
                    for (int m = 0; m < 4; ++m) { const float q = hstab[(ai * HALF + wr * 64 + m * 16 + fr) * 4 + hq];
#pragma unroll
                        for (int bj = 0; bj < 2; ++bj)
#pragma unroll
                            for (int n = 0; n < 2; ++n) acc[ai][bj][m][n] = acc[ai][bj][m][n] * q; } } }
            const char* a1 = Ab + (size_t)(t + 1) * kstep;
            const char* a2 = last ? Ab : Ab + (size_t)(t + 2) * kstep; const char* b2 = last ? nB : cB + (size_t)(t + 2) * kstepB;
            const char* a3 = a2 + kstep; const char* b3 = b2 + kstepB;
            unsigned o2[2][2];
#pragma unroll
            for (int h = 0; h < 2; ++h)
#pragma unroll
                for (int i = 0; i < 2; ++i) o2[h][i] = last ? offN[h][i] : offC[h][i];
            if constexpr (BAL) {
            const char* b1 = cB + (size_t)(t + 1) * kstepB;
            PG8_LDB(B0, 0, 0); PG8_LDB(B1, 0, 1); PG8_SCHED; PG8_LDA(At, 0, 0); PG8_STAGE(PG8_SA(1, 1), a1, offC[1]); PG8_STAGE(PG8_SB(1, 1), b1 + hstep, voffB);
            PG8_WAIT_V(8); PG8_WAIT_L(0); PG8_BAR; PG8_MMA(0, 0, At, B0); PG8_MMA(0, 1, At, B1); PG8_BAR; PG8_SCHED;
            PG8_LDA(At, 0, 1); PG8_STAGE(PG8_SB(0, 0), b2, voffB); PG8_STAGE(PG8_SA(0, 0), a2, o2[0]);
            PG8_WAIT_V(4); PG8_WAIT_L(0); PG8_BAR; PG8_MMA(1, 0, At, B0); PG8_MMA(1, 1, At, B1); PG8_BAR; PG8_SCHED;
            PG8_LDB(B0, 1, 0); PG8_LDB(B1, 1, 1); PG8_SCHED; PG8_LDA(At, 1, 0); PG8_STAGE(PG8_SA(0, 1), a2, o2[1]); PG8_STAGE(PG8_SB(0, 1), b2 + hstep, voffB);
            PG8_WAIT_V(8); PG8_WAIT_L(0); PG8_BAR; PG8_MMA(0, 0, At, B0); PG8_MMA(0, 1, At, B1); PG8_BAR; PG8_SCHED;
            PG8_LDA(At, 1, 1); PG8_STAGE(PG8_SB(1, 0), b3, voffB); PG8_STAGE(PG8_SA(1, 0), a3, o2[0]);
            PG8_WAIT_V(4); PG8_WAIT_L(0); PG8_BAR; PG8_MMA(1, 0, At, B0); PG8_MMA(1, 1, At, B1); PG8_BAR; PG8_SCHED;
            } else {
            PG8_LDB(B0, 0, 0); PG8_LDB(B1, 0, 1); PG8_SCHED; PG8_LDA(At, 0, 0); PG8_STAGE(PG8_SA(1, 1), a1, offC[1]);
            PG8_WAIT_V(8); PG8_WAIT_L(0); PG8_BAR; PG8_MMA(0, 0, At, B0); PG8_MMA(0, 1, At, B1); PG8_BAR; PG8_SCHED;
            PG8_LDA(At, 0, 1); PG8_STAGE(PG8_SB(0, 0), b2, voffB); PG8_STAGE(PG8_SB(0, 1), b2 + hstep, voffB); PG8_STAGE(PG8_SA(0, 0), a2, o2[0]);
            PG8_WAIT_V(8); PG8_WAIT_L(0); PG8_BAR; PG8_MMA(1, 0, At, B0); PG8_MMA(1, 1, At, B1); PG8_BAR; PG8_SCHED;
            PG8_LDB(B0, 1, 0); PG8_LDB(B1, 1, 1); PG8_SCHED; PG8_LDA(At, 1, 0); PG8_STAGE(PG8_SA(0, 1), a2, o2[1]);
            PG8_WAIT_V(8); PG8_WAIT_L(0); PG8_BAR; PG8_MMA(0, 0, At, B0); PG8_MMA(0, 1, At, B1); PG8_BAR; PG8_SCHED;
            PG8_LDA(At, 1, 1); PG8_STAGE(PG8_SB(1, 0), b3, voffB); PG8_STAGE(PG8_SB(1, 1), b3 + hstep, voffB); PG8_STAGE(PG8_SA(1, 0), a3, o2[0]);
            PG8_WAIT_V(8); PG8_WAIT_L(0); PG8_BAR; PG8_MMA(1, 0, At, B0); PG8_MMA(1, 1, At, B1); PG8_BAR; PG8_SCHED;
            }
        }
        if constexpr (HS) {
#pragma unroll
            for (int ai = 0; ai < 2; ++ai)
#pragma unroll
                for (int m = 0; m < 4; ++m) { const float q = hstab[(ai * HALF + wr * 64 + m * 16 + fr) * 4 + 3];
#pragma unroll
                    for (int bj = 0; bj < 2; ++bj)
#pragma unroll
                        for (int n = 0; n < 2; ++n) acc[ai][bj][m][n] = acc[ai][bj][m][n] * q; } }
        if constexpr (F8) asm volatile("s_nop 15\n\ts_nop 15" ::: "memory");
        if (wr == 0) PG8_BAR;
        E(acc, cur, wr, wc, fr, fq);
        if (!has_next) break;
#pragma unroll
        for (int a = 0; a < 2; ++a)
#pragma unroll
            for (int b = 0; b < 2; ++b)
#pragma unroll
                for (int m = 0; m < 4; ++m)
#pragma unroll
                    for (int n = 0; n < 2; ++n) acc[a][b][m][n] = (f32x4){0.f, 0.f, 0.f, 0.f};
        cur = nxt; cB = nB; ++ui;
#pragma unroll
        for (int h = 0; h < 2; ++h)
#pragma unroll
            for (int i = 0; i < 2; ++i) offC[h][i] = offN[h][i];
        if (wr == 1) PG8_BAR;
    }
    PG8_WAIT_V(0);
    PG8_BAR;
#undef PG8_SA
#undef PG8_SB
#undef PG8_STAGE
#undef PG8_LDA
#undef PG8_LDB
#undef PG8_MMA
#undef PG8_LD8
#undef PG8_WAIT_V
#undef PG8_WAIT_L
#undef PG8_BAR
#undef PG8_SCHED
}
}

constexpr int NWAVES = 8;
#ifndef MK_PER_PHASE
#define MK_PER_PHASE 0
#endif
constexpr int BATCH = 8, SEQ = 8192, D = 1024, T = BATCH * SEQ;
constexpr int RH = 4, DK = 256, DV = 512, CH = 128, NCH = SEQ / CH;
constexpr int FF = 3584, NE = 8;
constexpr float EPS = 1e-6f;
constexpr int NPH = 17;
#ifndef MK_FFN8
#define MK_FFN8 1
#endif
constexpr bool FFN8 = MK_FFN8 != 0;
constexpr float W8_SCALE = 32.0f, H8_SCALE = 8.0f, Y8_SCALE = 16.0f;

constexpr size_t MiB = 1u << 20;
constexpr size_t WS_CTL = 0, CTL_ZERO_BYTES = 4 * MiB;
constexpr size_t WS_SSQH = 2 * MiB;
constexpr size_t WS_SSQ1 = 1 * MiB, WS_SSQ2 = WS_SSQ1 + 512 * 1024;
constexpr size_t WS_WRIN = 4 * MiB;
constexpr size_t WS_WROUT = WS_WRIN + 12 * MiB;
constexpr size_t WS_WFGU = WS_WROUT + 4 * MiB;
constexpr size_t WS_WFD = WS_WFGU + 14 * MiB;
constexpr size_t WS_WCIN = WS_WFD + 7 * MiB;
constexpr size_t WS_WCOUT = WS_WCIN + 6 * MiB;
constexpr size_t WS_WMGU = WS_WCOUT + 2 * MiB;
constexpr size_t WS_WMD = WS_WMGU + 112 * MiB;
constexpr size_t WS_ROPE = WS_WMD + 56 * MiB;
constexpr size_t WS_E01 = WS_ROPE + 8 * MiB;
constexpr size_t WS_W01 = WS_E01 + 256 * 1024;
constexpr size_t WS_POS = WS_W01 + 512 * 1024;
constexpr int NPMAX = 2 * T + NE * 256;
constexpr size_t WS_IDX = WS_POS + 512 * 1024;
constexpr size_t WS_GW = WS_IDX + 1 * MiB;
constexpr size_t WS_PRS = WS_GW + 1 * MiB;
constexpr size_t WS_RSTD3 = WS_PRS + 1 * MiB;
constexpr size_t WS_ACT = 232 * MiB;
static_assert(WS_RSTD3 + 256 * 1024 <= WS_ACT, "fixed region");
constexpr size_t SLOT = 128 * MiB;
constexpr size_t WS_A0 = WS_ACT, WS_A1 = WS_ACT + SLOT, WS_A2 = WS_ACT + 2 * SLOT, WS_A3 = WS_ACT + 3 * SLOT, WS_A4 = WS_ACT + 4 * SLOT, WS_A5 = WS_ACT + 5 * SLOT;
constexpr size_t WS_END = 1024 * MiB;
constexpr size_t WS_YP = WS_A1;
constexpr size_t WS_A8 = WS_A1 + 132 * MiB;
constexpr size_t WS_HM = WS_A1 + 196 * MiB;
constexpr int HM_TILES = (int)((WS_END - WS_HM) / ((size_t)256 * FF));
static_assert(HM_TILES >= NPMAX / 256, "the whole MoE hidden must fit");
constexpr int CW_BAR = 4096;
constexpr int CW_MOE = 131072;
#define XCD_BAR_WORDS 3456
static_assert((CW_BAR + NPH * XCD_BAR_WORDS) <= CW_MOE && (CW_MOE + 16 * 64) * 4 <= (int)CTL_ZERO_BYTES, "ctl");

constexpr int RING_BYTES = 131072;
constexpr int LDS_BYTES = 163840;
constexpr int MISC_OFF = LDS_BYTES - 512;

#define GAS __attribute__((address_space(1)))
#define LAS __attribute__((address_space(3)))
typedef unsigned short bf16;
typedef unsigned v4u __attribute__((ext_vector_type(4)));
typedef unsigned v2u __attribute__((ext_vector_type(2)));
typedef float f32x4 __attribute__((ext_vector_type(4)));
typedef float f32x2 __attribute__((ext_vector_type(2)));
typedef short bf16x8 __attribute__((ext_vector_type(8)));
typedef short bf16x4 __attribute__((ext_vector_type(4)));
#define LDS_WAIT() asm volatile("s_waitcnt lgkmcnt(0)" ::: "memory")
__device__ __forceinline__ unsigned f2bf(float f) { unsigned u = __builtin_bit_cast(unsigned, f); return (u + 0x7fffu + ((u >> 16) & 1u)) >> 16; }
__device__ __forceinline__ unsigned pk2(float lo, float hi) { return f2bf(lo) | (f2bf(hi) << 16); }
typedef __bf16 bf16c2 __attribute__((ext_vector_type(2)));
__device__ __forceinline__ unsigned pk2c(float lo, float hi) { const f32x2 f = {lo, hi}; return __builtin_bit_cast(unsigned, __builtin_convertvector(f, bf16c2)); }
__device__ __forceinline__ float bflo(unsigned w) { return __builtin_bit_cast(float, w << 16); }
__device__ __forceinline__ float bfhi(unsigned w) { return __builtin_bit_cast(float, w & 0xffff0000u); }

#define XB_TMO      128
#define XB_XCNT(j)  (256  + 64 * (j))
#define XB_XSUB(j)  (1280 + 64 * (j))
#define XB_XGEN(j)  (2304 + 64 * (j))
#define XB_TOP      3328
#define XB_TOPGEN   3392
#define XB_SPIN_CAP (1u << 18)
__device__ __forceinline__ unsigned xb_ld(unsigned* p)              { return __hip_atomic_load(p, __ATOMIC_RELAXED, __HIP_MEMORY_SCOPE_AGENT); }
__device__ __forceinline__ unsigned xb_add(unsigned* p, unsigned v) { return __hip_atomic_fetch_add(p, v, __ATOMIC_RELAXED, __HIP_MEMORY_SCOPE_AGENT); }
__device__ __forceinline__ unsigned xb_xcc_id() { return (unsigned)__builtin_amdgcn_s_getreg((3 << 11) | 20) & 0xFu; }
#define XB_SPIN(cond, bar) do { unsigned _sp = 0; while (cond) { __builtin_amdgcn_s_sleep(1); \
    if ((++_sp & 255u) == 0u) { if (xb_ld(&(bar)[XB_TMO])) break; if (_sp > XB_SPIN_CAP) { atomicAdd(&(bar)[XB_TMO], 1u); break; } } } } while (0)
struct XcdBarrier { unsigned* bar; unsigned x; volatile LAS unsigned* st; };
__device__ __forceinline__ XcdBarrier xcd_barrier_post(unsigned* bar, volatile LAS unsigned* st) {
    XcdBarrier b; b.bar = bar; b.x = xb_xcc_id(); b.st = st;
    if (threadIdx.x == 0) st[2] = xb_add(&bar[XB_XCNT(b.x)], 1u);
    return b;
}
__device__ __forceinline__ void xcd_barrier_complete(unsigned* bar, unsigned x, unsigned& nloc, unsigned& nx) {
    const unsigned G = gridDim.x * gridDim.y * gridDim.z;
    unsigned sum, cnt, mine, sp = 0u;
    for (;;) {
        sum = 0u; cnt = 0u; mine = 0u;
#pragma unroll
        for (unsigned j = 0; j < 16; ++j) { const unsigned c = xb_ld(&bar[XB_XCNT(j)]); sum += c; cnt += (c > 0u) ? 1u : 0u; mine = (j == x) ? c : mine; }
        if (sum == G) break;
        __builtin_amdgcn_s_sleep(1);
        if ((++sp & 255u) == 0u) { if (xb_ld(&bar[XB_TMO])) break; if (sp > XB_SPIN_CAP) { atomicAdd(&bar[XB_TMO], 1u); break; } }
    }
    nloc = mine > 0u ? mine : 1u; nx = cnt > 0u ? cnt : 1u;
}
__device__ __forceinline__ void xcd_barrier(const XcdBarrier& b) {
    asm volatile("s_waitcnt vmcnt(0)" ::: "memory");
    __syncthreads();
    if (threadIdx.x == 0) {
        unsigned* bar = b.bar;
        __builtin_amdgcn_s_waitcnt(0);
        unsigned nloc = b.st[0], nx = b.st[1];
        if (nloc == 0u) { xcd_barrier_complete(bar, b.x, nloc, nx); b.st[0] = nloc; b.st[1] = nx; }
        const unsigned old = xb_add(&bar[XB_XSUB(b.x)], 1u);
        const unsigned gen = old / nloc;
        if (old + 1u == (gen + 1u) * nloc) {
            __builtin_amdgcn_fence(__ATOMIC_RELEASE, "agent");
            asm volatile("s_waitcnt vmcnt(0)" ::: "memory");
            const unsigned og = xb_add(&bar[XB_TOP], 1u);
            const unsigned tg = og / nx;
            if (og + 1u == (tg + 1u) * nx) xb_add(&bar[XB_TOPGEN], 1u);
            else XB_SPIN(xb_ld(&bar[XB_TOPGEN]) == tg, bar);
            __builtin_amdgcn_fence(__ATOMIC_ACQUIRE, "agent");
            xb_add(&bar[XB_XGEN(b.x)], 1u);
            asm volatile("s_waitcnt vmcnt(0)" ::: "memory");
        } else {
            XB_SPIN(xb_ld(&bar[XB_XGEN(b.x)]) == gen, bar);
            __builtin_amdgcn_fence(__ATOMIC_ACQUIRE, "agent");
            asm volatile("s_waitcnt vmcnt(0)" ::: "memory");
        }
    }
    __syncthreads();
}

struct Frame {
    LAS unsigned char* lds;
    unsigned* ctl;
    int tid, lane, wave, vcu, vcu2, G;
    const float* in[18];
    float* out; unsigned char* ws;
};
__device__ __forceinline__ int opq(int v) { asm volatile("" : "+v"(v)); return v; }
__device__ __forceinline__ float wave_sum(float v) {
#pragma unroll
    for (int o = 1; o < 64; o <<= 1) v += __shfl_xor(v, o);
    return v;
}

__device__ __forceinline__ void p0_transpose_item(const float* W, int K, int N, bf16* WT, int mode, LAS float* scr, int item, int lane, const float* gain = nullptr) {
    const int nblk = N / 32, kb = item / nblk, nb = item % nblk, k0 = 64 * kb, n0 = 32 * nb;
    const int drow0 = mode == 0 ? n0 : mode == 3 ? (n0 < 1024 ? n0 : n0 < 2048 ? 1024 + ((n0 - 1024) >> 7) * 256 + ((n0 - 1024) & 127) : 1024 + ((n0 - 2048) >> 7) * 256 + 128 + ((n0 - 2048) & 127))
                                  : ((n0 >> 7) * 256 + (n0 & 127) + (mode == 2 ? 128 : 0));
    { const int r = lane >> 3, c4 = lane & 7; f32x4 v[8];
#pragma unroll
      for (int i = 0; i < 8; ++i) v[i] = *(const GAS f32x4*)(W + (size_t)(k0 + 8 * i + r) * N + n0 + 4 * c4);
#pragma unroll
      for (int i = 0; i < 8; ++i) { const float gsc = gain ? gain[k0 + 8 * i + r] : 1.0f; LAS float* d = scr + (8 * i + r) * 33 + 4 * c4;
          d[0] = v[i].x * gsc; d[1] = v[i].y * gsc; d[2] = v[i].z * gsc; d[3] = v[i].w * gsc; } }
    LDS_WAIT(); asm volatile("" ::: "memory");
    const int c = lane & 7;
    unsigned char* img = (unsigned char*)WT + ((size_t)((drow0 >> 8) * 2 + ((drow0 >> 7) & 1)) * (K / 64) + kb) * 16384;
#pragma unroll
    for (int j = 0; j < 4; ++j) { const int n = (lane >> 3) + 8 * j; const LAS float* s = scr + (8 * c) * 33 + n;
        v4u o; o.x = pk2(s[0 * 33], s[1 * 33]); o.y = pk2(s[2 * 33], s[3 * 33]); o.z = pk2(s[4 * 33], s[5 * 33]); o.w = pk2(s[6 * 33], s[7 * 33]);
        const int slot = 16 * ((n >> 2) & 1) + 4 * (n >> 3) + (n & 3), R = (drow0 & 96) + slot;
        *(GAS v4u*)(img + pg8::lds_byte(R, 8 * c)) = o; }
    LDS_WAIT(); asm volatile("" ::: "memory");
}
__device__ __forceinline__ void p0_item_f8(const float* W, int K, int N, unsigned char* WT, int mode, LAS float* scr, int item, int lane, const float* gain, float scale) {
    const int nblk = N / 32, kb = item / nblk, nb = item % nblk, k0 = 64 * kb, n0 = 32 * nb;
    const int drow0 = mode == 0 ? n0 : ((n0 >> 7) * 256 + (n0 & 127) + (mode == 2 ? 128 : 0));
    { const int r = lane >> 3, c4 = lane & 7; f32x4 v[8];
#pragma unroll
      for (int i = 0; i < 8; ++i) v[i] = *(const GAS f32x4*)(W + (size_t)(k0 + 8 * i + r) * N + n0 + 4 * c4);
#pragma unroll
      for (int i = 0; i < 8; ++i) { const float gsc = (gain ? gain[k0 + 8 * i + r] : 1.0f) * scale; LAS float* d = scr + (8 * i + r) * 33 + 4 * c4;
          d[0] = v[i].x * gsc; d[1] = v[i].y * gsc; d[2] = v[i].z * gsc; d[3] = v[i].w * gsc; } }
    LDS_WAIT(); asm volatile("" ::: "memory");
    const int c = lane & 7;
    unsigned char* img = WT + ((size_t)((drow0 >> 8) * 2 + ((drow0 >> 7) & 1)) * (K / 128) + (k0 >> 7)) * 16384;
#pragma unroll
    for (int j = 0; j < 4; ++j) { const int n = (lane >> 3) + 8 * j; const LAS float* s = scr + (8 * c) * 33 + n;
        v2u o; o.x = pg8::pk4_fp8(s[0 * 33], s[1 * 33], s[2 * 33], s[3 * 33]); o.y = pg8::pk4_fp8(s[4 * 33], s[5 * 33], s[6 * 33], s[7 * 33]);
        const int slot = 16 * ((n >> 2) & 1) + 4 * (n >> 3) + (n & 3), R = (drow0 & 96) + slot;
        *(GAS v2u*)(img + pg8::lds_byteB(R, (k0 & 127) + 8 * c)) = o; }
    LDS_WAIT(); asm volatile("" ::: "memory");
}
__device__ __forceinline__ void norm_phase(Frame& F, const float* src, const float* gain, bf16* dst) {
    const int tid_ = opq(F.tid), lane_ = tid_ & 63;
    const int gw = F.vcu * NWAVES + F.wave, NGW = F.G * NWAVES, lane = lane_;
    f32x4 gg[4];
#pragma unroll
    for (int j = 0; j < 4; ++j) gg[j] = ((const GAS f32x4*)gain + lane)[64 * j];
    for (int m = 2 * gw; m < T; m += 2 * NGW) {
        const GAS f32x4* xa = (const GAS f32x4*)(src + (size_t)m * D) + lane; const GAS f32x4* xb = xa + D / 4;
        f32x4 va[4], vb[4]; float sa = 0.f, sb = 0.f;
#pragma unroll
        for (int j = 0; j < 4; ++j) { va[j] = xa[64 * j]; vb[j] = xb[64 * j]; }
#pragma unroll
        for (int j = 0; j < 4; ++j) { sa += (va[j].x * va[j].x + va[j].y * va[j].y) + (va[j].z * va[j].z + va[j].w * va[j].w); sb += (vb[j].x * vb[j].x + vb[j].y * vb[j].y) + (vb[j].z * vb[j].z + vb[j].w * vb[j].w); }
        const float ra = 1.0f / sqrtf(wave_sum(sa) * (1.f / D) + EPS), rb = 1.0f / sqrtf(wave_sum(sb) * (1.f / D) + EPS);
        GAS v2u* oa = (GAS v2u*)(dst + (size_t)m * D) + lane; GAS v2u* ob = oa + D / 4;
#pragma unroll
        for (int j = 0; j < 4; ++j) { v2u w; w.x = pk2(va[j].x * ra * gg[j].x, va[j].y * ra * gg[j].y); w.y = pk2(va[j].z * ra * gg[j].z, va[j].w * ra * gg[j].w); oa[64 * j] = w;
            v2u w2; w2.x = pk2(vb[j].x * rb * gg[j].x, vb[j].y * rb * gg[j].y); w2.y = pk2(vb[j].z * rb * gg[j].z, vb[j].w * rb * gg[j].w); ob[64 * j] = w2; }
    }
}
__device__ __forceinline__ void p0_prologue(Frame& F) {
    const int tid_ = opq(F.tid), lane_ = tid_ & 63;
    LAS float* scr = (LAS float*)(F.lds + F.wave * 16384);
    const int gw = F.vcu * NWAVES + F.wave, NGW = F.G * NWAVES;
    constexpr int I_RIN = 16 * 192, I_ROUT = 32 * 32, I_FG = 16 * 112, I_FD = 56 * 32, I_CIN = 16 * 96, I_COUT = 16 * 32;
    constexpr int NITEMS = I_RIN + I_ROUT + 2 * I_FG + I_FD + I_CIN + I_COUT + 8 * (2 * I_FG + I_FD);
    unsigned char* ws = F.ws;
    for (int it = gw; it < NITEMS; it += NGW) {
        int r = it;
        if (r < I_RIN) { p0_transpose_item(F.in[2], 1024, 6144, (bf16*)(ws + WS_WRIN), 0, scr, r, lane_); continue; } r -= I_RIN;
        if (r < I_ROUT) { p0_transpose_item(F.in[3], 2048, 1024, (bf16*)(ws + WS_WROUT), 0, scr, r, lane_); continue; } r -= I_ROUT;
        if (r < I_FG) { p0_transpose_item(F.in[5], 1024, FF, (bf16*)(ws + WS_WFGU), 1, scr, r, lane_, F.in[4]); continue; } r -= I_FG;
        if (r < I_FG) { p0_transpose_item(F.in[6], 1024, FF, (bf16*)(ws + WS_WFGU), 2, scr, r, lane_, F.in[4]); continue; } r -= I_FG;
        if (r < I_FD) { if (FFN8) p0_item_f8(F.in[7], FF, 1024, ws + WS_WFD, 0, scr, r, lane_, nullptr, W8_SCALE); else p0_transpose_item(F.in[7], FF, 1024, (bf16*)(ws + WS_WFD), 0, scr, r, lane_); continue; } r -= I_FD;
        if (r < I_CIN) { p0_transpose_item(F.in[9], 1024, 3072, (bf16*)(ws + WS_WCIN), 3, scr, r, lane_, F.in[8]); continue; } r -= I_CIN;
        if (r < I_COUT) { p0_transpose_item(F.in[11], 1024, 1024, (bf16*)(ws + WS_WCOUT), 0, scr, r, lane_); continue; } r -= I_COUT;
        if (r < 8 * I_FG) { const int e = r / I_FG; p0_item_f8(F.in[14] + (size_t)e * 1024 * FF, 1024, FF, ws + WS_WMGU + (size_t)e * 7168 * 1024, 1, scr, r % I_FG, lane_, F.in[12], W8_SCALE); continue; } r -= 8 * I_FG;
        if (r < 8 * I_FG) { const int e = r / I_FG; p0_item_f8(F.in[15] + (size_t)e * 1024 * FF, 1024, FF, ws + WS_WMGU + (size_t)e * 7168 * 1024, 2, scr, r % I_FG, lane_, F.in[12], W8_SCALE); continue; } r -= 8 * I_FG;
        { const int e = r / I_FD; p0_item_f8(F.in[16] + (size_t)e * FF * 1024, FF, 1024, ws + WS_WMD + (size_t)e * 1024 * FF, 0, scr, r % I_FD, lane_, nullptr, W8_SCALE); }
    }
    {
        const int gt = F.vcu * (NWAVES * 64) + tid_, NT_ = F.G * (NWAVES * 64);
        const int jg = gt & 31, j0 = 4 * jg; float ivf[4];
#pragma unroll
        for (int x = 0; x < 4; ++x) ivf[x] = (float)exp(-(double)(2 * (j0 + x)) * (1.0 / 256.0) * 9.210340371976184);
        const int twc = j0 >> 5, tfq = (j0 & 31) >> 3, thalf = (j0 & 7) >> 2;
        for (int it = gt; it < 8192 * 32; it += NT_) { const int pos = it >> 5; f32x4 cs, sn;
#pragma unroll
            for (int x = 0; x < 4; ++x) { const float ang = (float)pos * ivf[x];
                const float pr = ang * 0.15915494f, er = __builtin_fmaf(ang, 0.15915494f, -pr) + ang * 6.4206382e-9f;
                const float t = (pr - __builtin_floorf(pr)) + er;
                cs[x] = __builtin_amdgcn_cosf(t); sn[x] = __builtin_amdgcn_sinf(t); }
            float* tb = (float*)(ws + WS_ROPE) + ((((size_t)(pos >> 4) * 4 + twc) * 4) * 64 + tfq * 16 + (pos & 15)) * 4;
            *(f32x4*)(tb + thalf * 256) = cs; *(f32x4*)(tb + (2 + thalf) * 256) = sn; } }
    norm_phase(F, F.in[0], F.in[1], (bf16*)(ws + WS_A0));
}

constexpr int KS_STRIDE = 544, VS_STRIDE = 160, ST_STRIDE = 544;
constexpr int KS_OFF = 0, VS_OFF = 128 * KS_STRIDE, ST_OFF = VS_OFF + 128 * VS_STRIDE, SCAN_LDS = ST_OFF + 64 * ST_STRIDE;
static_assert(SCAN_LDS <= RING_BYTES, "scan LDS");
constexpr int ST2_BYTES = 64 * ST_STRIDE;
static_assert(ST_OFF + 2 * ST2_BYTES <= MISC_OFF, "scan LDS (two state images)");
template <int O0, int O1, int O2, int O3, int O4, int O5, int O6, int O7>
__device__ __forceinline__ void tr8(unsigned base, bf16x4& r0, bf16x4& r1, bf16x4& r2, bf16x4& r3, bf16x4& r4, bf16x4& r5, bf16x4& r6, bf16x4& r7) {
    asm volatile("ds_read_b64_tr_b16 %0, %8 offset:%9\n\tds_read_b64_tr_b16 %1, %8 offset:%10\n\tds_read_b64_tr_b16 %2, %8 offset:%11\n\tds_read_b64_tr_b16 %3, %8 offset:%12\n\t"
                 "ds_read_b64_tr_b16 %4, %8 offset:%13\n\tds_read_b64_tr_b16 %5, %8 offset:%14\n\tds_read_b64_tr_b16 %6, %8 offset:%15\n\tds_read_b64_tr_b16 %7, %8 offset:%16\n\ts_waitcnt lgkmcnt(0)"
                 : "=&v"(r0), "=&v"(r1), "=&v"(r2), "=&v"(r3), "=&v"(r4), "=&v"(r5), "=&v"(r6), "=&v"(r7)
                 : "v"(base), "n"(O0), "n"(O1), "n"(O2), "n"(O3), "n"(O4), "n"(O5), "n"(O6), "n"(O7) : "memory");
}
__device__ __forceinline__ bf16x8 cat8(bf16x4 a, bf16x4 b) { return (bf16x8){a[0], a[1], a[2], a[3], b[0], b[1], b[2], b[3]}; }
template <int KS> __device__ __forceinline__ void load_vf(unsigned vbase, bf16x8& f0, bf16x8& f1, bf16x8& f2, bf16x8& f3) {
    constexpr int B = KS * 32 * VS_STRIDE, T1 = 16 * VS_STRIDE;
    bf16x4 a0, a1, b0, b1, c0, c1, d0, d1;
    tr8<B, B + T1, B + 32, B + 32 + T1, B + 64, B + 64 + T1, B + 96, B + 96 + T1>(vbase, a0, a1, b0, b1, c0, c1, d0, d1);
    f0 = cat8(a0, a1); f1 = cat8(b0, b1); f2 = cat8(c0, c1); f3 = cat8(d0, d1);
}
template <int DB> __device__ __forceinline__ void load_kf(unsigned kbase, bf16x8& f0, bf16x8& f1, bf16x8& f2, bf16x8& f3) {
    constexpr int B = DB * 32, S = 32 * KS_STRIDE, T1 = 16 * KS_STRIDE;
    bf16x4 a0, a1, b0, b1, c0, c1, d0, d1;
    tr8<B, B + T1, B + S, B + S + T1, B + 2 * S, B + 2 * S + T1, B + 3 * S, B + 3 * S + T1>(kbase, a0, a1, b0, b1, c0, c1, d0, d1);
    f0 = cat8(a0, a1); f1 = cat8(b0, b1); f2 = cat8(c0, c1); f3 = cat8(d0, d1);
}
#define SC_SCHED __builtin_amdgcn_sched_barrier(0)
#define SC_BAR asm volatile("s_waitcnt lgkmcnt(0)\n\ts_barrier" ::: "memory")
#define SC_TR(p) __builtin_amdgcn_ds_read_tr16_b64_v4i16((LAS bf16x4*)(p))
template <int V, bool DRY> __device__ __forceinline__ void scan3_owave(LAS unsigned char* lds, const bf16* Qg, const bf16* Gg, bf16* Vg, unsigned long long* ssqh, size_t seq0, int h, int s, int lane, size_t seq0o) {
    constexpr int rbA = V, rbB = 7 - V;
    const int r16 = lane & 15, g4 = lane >> 4, trq = (lane & 15) >> 2, trp = lane & 3;
    const bf16* QpA = Qg + ((seq0 >> 4) + rbA) * 16384 + h * 4096 + lane * 8; const bf16* QpB = Qg + ((seq0 >> 4) + rbB) * 16384 + h * 4096 + lane * 8;
    const int gq = (g4 >> 1) + 2 * (g4 & 1), gpos = (r16 * 64 + gq * 16) ^ ((r16 >> 3) << 5);
    const size_t orowA = ((seq0 >> 7) * 32 + 8 * h + s) * (size_t)pg8::HTB + rbA * 2048 + gpos, orowB = ((seq0 >> 7) * 32 + 8 * h + s) * (size_t)pg8::HTB + rbB * 2048 + gpos;
    unsigned long long* SSpA = ssqh + (seq0o + 16 * rbA + r16) * 4 + h; unsigned long long* SSpB = ssqh + (seq0o + 16 * rbB + r16) * 4 + h;
    const size_t srowA = ((seq0o >> 7) * 32 + 8 * h + s) * (size_t)pg8::HTB + rbA * 2048 + gpos, srowB = ((seq0o >> 7) * 32 + 8 * h + s) * (size_t)pg8::HTB + rbB * 2048 + gpos;
    LAS unsigned char* kq = lds + KS_OFF + r16 * KS_STRIDE + g4 * 16;
    LAS unsigned char* vq = lds + VS_OFF + (4 * g4 + trq) * VS_STRIDE + 8 * trp;
    f32x4 U[16];
#define QFA(ks) __builtin_bit_cast(bf16x8, U[ks])
#define QFB(ks) __builtin_bit_cast(bf16x8, U[8 + (ks)])
#pragma unroll
    for (int ks = 0; ks < 8; ++ks) { U[ks] = __builtin_bit_cast(f32x4, *(const GAS bf16x8*)(QpA + 512 * ks)); U[8 + ks] = __builtin_bit_cast(f32x4, *(const GAS bf16x8*)(QpB + 512 * ks)); }
#pragma unroll 1
    for (int n = 0; n < NCH; ++n) {
        const int nn = (n + 1 < NCH) ? n + 1 : n;
        LAS unsigned char* sq = lds + ST_OFF + (n & 1) * ST2_BYTES + r16 * ST_STRIDE + g4 * 16;
        SC_BAR;
        bf16x8 kf[2][8], sf[2][4], vf[2][4];
#define SC_LOADK(buf, jb) do { _Pragma("unroll") for (int kk = 0; kk < 8; ++kk) kf[buf][kk] = *(const LAS bf16x8*)(kq + (jb) * 16 * KS_STRIDE + kk * 64); } while (0)
#define SC_LOADS(buf, ks) do { _Pragma("unroll") for (int eb = 0; eb < 4; ++eb) sf[buf][eb] = *(const LAS bf16x8*)(sq + eb * 16 * ST_STRIDE + (ks) * 64); } while (0)
#define SC_LOADV(buf, KS) do { _Pragma("unroll") for (int eb = 0; eb < 4; ++eb) vf[buf][eb] = cat8(SC_TR(vq + (KS) * 32 * VS_STRIDE + 32 * eb), SC_TR(vq + (KS) * 32 * VS_STRIDE + 32 * eb + 16 * VS_STRIDE)); } while (0)
        v4u pwA[4], pwB[4];
#pragma unroll
        for (int ks = 0; ks < 4; ++ks) { pwA[ks] = (v4u){0u, 0u, 0u, 0u}; pwB[ks] = (v4u){0u, 0u, 0u, 0u}; }
        SC_LOADK(0, 0);
#pragma unroll
        for (int jb = 0; jb <= rbB; ++jb) {
            if (jb < rbB) SC_LOADK((jb + 1) & 1, jb + 1); else SC_LOADS(0, 0);
            SC_SCHED;
            f32x4 sa = (f32x4){0.f, 0.f, 0.f, 0.f}, sb = (f32x4){0.f, 0.f, 0.f, 0.f};
#pragma unroll
            for (int kk = 0; kk < 8; ++kk) { sb = __builtin_amdgcn_mfma_f32_16x16x32_bf16(kf[jb & 1][kk], QFB(kk), sb, 0, 0, 0);
                if (jb <= rbA) sa = __builtin_amdgcn_mfma_f32_16x16x32_bf16(kf[jb & 1][kk], QFA(kk), sa, 0, 0, 0); }
            if (jb == rbB) {
#pragma unroll
                for (int x = 0; x < 4; ++x) if (4 * g4 + x > r16) sb[x] = 0.f; }
            if (jb == rbA) {
#pragma unroll
                for (int x = 0; x < 4; ++x) if (4 * g4 + x > r16) sa[x] = 0.f; }
            if ((jb & 1) == 0) { pwB[jb >> 1].x = pk2c(sb[0], sb[1]); pwB[jb >> 1].y = pk2c(sb[2], sb[3]); if (jb <= rbA) { pwA[jb >> 1].x = pk2c(sa[0], sa[1]); pwA[jb >> 1].y = pk2c(sa[2], sa[3]); } }
            else { pwB[jb >> 1].z = pk2c(sb[0], sb[1]); pwB[jb >> 1].w = pk2c(sb[2], sb[3]); if (jb <= rbA) { pwA[jb >> 1].z = pk2c(sa[0], sa[1]); pwA[jb >> 1].w = pk2c(sa[2], sa[3]); } }
            SC_SCHED;
        }
        v4u gvA[2], gvB[2];
#pragma unroll
        for (int ch = 0; ch < 2; ++ch) { gvA[ch] = *(const GAS v4u*)((const char*)Gg + orowA + (size_t)n * (32 * pg8::HTB) + ch * 1024); gvB[ch] = *(const GAS v4u*)((const char*)Gg + orowB + (size_t)n * (32 * pg8::HTB) + ch * 1024); }
        f32x4 OA[4], OB[4];
#pragma unroll
        for (int eb = 0; eb < 4; ++eb) { OA[eb] = (f32x4){0.f, 0.f, 0.f, 0.f}; OB[eb] = (f32x4){0.f, 0.f, 0.f, 0.f}; }
#pragma unroll
        for (int ks = 0; ks < 8; ++ks) {
            if (ks < 7) SC_LOADS((ks + 1) & 1, ks + 1); else SC_LOADV(0, 0);
            SC_SCHED;
#pragma unroll
            for (int eb = 0; eb < 4; ++eb) { OA[eb] = __builtin_amdgcn_mfma_f32_16x16x32_bf16(sf[ks & 1][eb], QFA(ks), OA[eb], 0, 0, 0); OB[eb] = __builtin_amdgcn_mfma_f32_16x16x32_bf16(sf[ks & 1][eb], QFB(ks), OB[eb], 0, 0, 0); }
            SC_SCHED;
            U[ks] = __builtin_bit_cast(f32x4, *(const GAS bf16x8*)(QpA + (size_t)nn * CH * 1024 + 512 * ks)); U[8 + ks] = __builtin_bit_cast(f32x4, *(const GAS bf16x8*)(QpB + (size_t)nn * CH * 1024 + 512 * ks));
        }
#pragma unroll
        for (int KS = 0; KS <= rbB / 2; ++KS) {
            if (KS < rbB / 2) SC_LOADV((KS + 1) & 1, KS + 1);
            SC_SCHED;
#pragma unroll
            for (int eb = 0; eb < 4; ++eb) { OB[eb] = __builtin_amdgcn_mfma_f32_16x16x32_bf16(vf[KS & 1][eb], __builtin_bit_cast(bf16x8, pwB[KS]), OB[eb], 0, 0, 0);
                if (KS <= rbA / 2) OA[eb] = __builtin_amdgcn_mfma_f32_16x16x32_bf16(vf[KS & 1][eb], __builtin_bit_cast(bf16x8, pwA[KS]), OA[eb], 0, 0, 0); }
            SC_SCHED;
        }
        SC_BAR;
#define SCAN3_STORE(OX, GV, OROW, SSP) do { float ss = 0.f; v2u gq2[4], wv[4]; \
        _Pragma("unroll") for (int ch = 0; ch < 2; ++ch) { const auto s0 = __builtin_amdgcn_permlane16_swap(GV[ch].x, GV[ch].z, false, false); const auto s1 = __builtin_amdgcn_permlane16_swap(GV[ch].y, GV[ch].w, false, false); \
            gq2[2 * ch] = (v2u){s0[0], s1[0]}; gq2[2 * ch + 1] = (v2u){s0[1], s1[1]}; }     \
        _Pragma("unroll") for (int eb = 0; eb < 4; ++eb) { const float g0 = bflo(gq2[eb].x), g1 = bfhi(gq2[eb].x), g2 = bflo(gq2[eb].y), g3 = bfhi(gq2[eb].y); \
            ss += (OX[eb][0] * OX[eb][0] + OX[eb][1] * OX[eb][1]) + (OX[eb][2] * OX[eb][2] + OX[eb][3] * OX[eb][3]); \
            wv[eb].x = pk2c(pg8::silu_f(g0) * OX[eb][0], pg8::silu_f(g1) * OX[eb][1]); wv[eb].y = pk2c(pg8::silu_f(g2) * OX[eb][2], pg8::silu_f(g3) * OX[eb][3]); } \
        _Pragma("unroll") for (int ch = 0; ch < 2; ++ch) { const v4u w = pg8::widen16(wv[2 * ch], wv[2 * ch + 1]); \
            if (!DRY || w.x == 0x12345678u) *(GAS v4u*)((char*)Vg + OROW + (size_t)n * (32 * pg8::HTB) + ch * 1024) = w; } \
        ss += __shfl_xor(ss, 16); ss += __shfl_xor(ss, 32); \
        if (!DRY && g4 == 0) __hip_atomic_fetch_add(SSP + (size_t)n * CH * 4, (unsigned long long)(ss * 4294967296.0f), __ATOMIC_RELAXED, __HIP_MEMORY_SCOPE_AGENT); } while (0)
        SCAN3_STORE(OA, gvA, srowA, SSpA); SCAN3_STORE(OB, gvB, srowB, SSpB);
#undef SCAN3_STORE
#undef SC_LOADK
#undef SC_LOADS
#undef SC_LOADV
    }
#undef QFA
#undef QFB
}
template <bool DRY> __device__ __forceinline__ void scan3_swave(LAS unsigned char* lds, const char* Kub, const char* Vub, float gC, int v, int ts, int lane) {
    const int r16 = lane & 15, g4 = lane >> 4, trq = (lane & 15) >> 2, trp = lane & 3;
    LAS unsigned char* vq = lds + VS_OFF + (4 * g4 + trq) * VS_STRIDE + 8 * trp; LAS unsigned char* kq = lds + KS_OFF + (4 * g4 + trq) * KS_STRIDE + 128 * v + 8 * trp;
    const unsigned kvo = (unsigned)(ts * 16);
    const int pr0 = (ts >> 7) * 16 + ((ts & 63) >> 2), pc0 = ((ts >> 6) & 1) * 32 + (((ts & 3) ^ (((ts >> 5) & 1) << 1)) * 8);
    LAS unsigned char* kdst = lds + KS_OFF + pr0 * KS_STRIDE + pc0 * 2; LAS unsigned char* vdst = lds + VS_OFF + pr0 * VS_STRIDE + pc0 * 2;
#define KPIECE(nch, q) (*(const GAS v4u*)(Kub + (size_t)(nch) * (16 * pg8::HTB) + (q) * 4096 + kvo))
#define VPIECE(nch, q) (*(const GAS v4u*)(Vub + (size_t)(nch) * (32 * pg8::HTB) + (q) * 4096 + kvo))
    v4u kreg[16], vreg[4];
    f32x4 U[16];
#define SACC(db, eb) U[4 * (db) + (eb)]
#pragma unroll
    for (int i = 0; i < 16; ++i) U[i] = (f32x4){0.f, 0.f, 0.f, 0.f};
#pragma unroll
    for (int q = 0; q < 16; ++q) kreg[q] = KPIECE(0, q);
#pragma unroll
    for (int q = 0; q < 4; ++q) vreg[q] = VPIECE(0, q);
#pragma unroll 1
    for (int n = 0; n < NCH; ++n) {
        const int nn = (n + 1 < NCH) ? n + 1 : n;
#pragma unroll
        for (int q = 0; q < 16; ++q) *(LAS v4u*)(kdst + (q & 3) * 32 * KS_STRIDE + (q >> 2) * 128) = kreg[q];
#pragma unroll
        for (int q = 0; q < 4; ++q) *(LAS v4u*)(vdst + q * 32 * VS_STRIDE) = vreg[q];
        SC_BAR;
#pragma unroll
        for (int q = 0; q < 16; ++q) kreg[q] = KPIECE(nn, q);
#pragma unroll
        for (int q = 0; q < 4; ++q) vreg[q] = VPIECE(nn, q);
        bf16x8 kf[1][4], vf[1][4];
#define SC_LOADKV(buf, KS) do { _Pragma("unroll") for (int j = 0; j < 4; ++j) { \
            kf[buf][j] = cat8(SC_TR(kq + 32 * j + (KS) * 32 * KS_STRIDE), SC_TR(kq + 32 * j + (KS) * 32 * KS_STRIDE + 16 * KS_STRIDE)); \
            vf[buf][j] = cat8(SC_TR(vq + (KS) * 32 * VS_STRIDE + 32 * j), SC_TR(vq + (KS) * 32 * VS_STRIDE + 32 * j + 16 * VS_STRIDE)); } } while (0)
#pragma unroll
        for (int KS = 0; KS < 4; ++KS) {
            SC_LOADKV(0, KS);
            SC_SCHED;
#pragma unroll
            for (int db = 0; db < 4; ++db)
#pragma unroll
                for (int eb = 0; eb < 4; ++eb) SACC(db, eb) = __builtin_amdgcn_mfma_f32_16x16x32_bf16(kf[0][db], vf[0][eb], SACC(db, eb), 0, 0, 0);
            SC_SCHED;
        }
#undef SC_LOADKV
        LAS unsigned char* stn = lds + ST_OFF + ((n + 1) & 1) * ST2_BYTES;
#pragma unroll
        for (int db = 0; db < 4; ++db)
#pragma unroll
            for (int eb = 0; eb < 4; ++eb) { SACC(db, eb) = SACC(db, eb) * gC; v2u wv; wv.x = pk2c(SACC(db, eb)[0], SACC(db, eb)[1]); wv.y = pk2c(SACC(db, eb)[2], SACC(db, eb)[3]);
                *(LAS v2u*)(stn + (16 * eb + r16) * ST_STRIDE + (64 * v + 16 * db + 4 * g4) * 2) = wv; }
        SC_BAR;
    }
#undef KPIECE
#undef VPIECE
#undef SACC
}
template <bool DRY, bool REDIR = false> __device__ __forceinline__ void ret_scan_phase3(Frame& F) {
    int tid_ = F.tid; asm volatile("" : "+v"(tid_));
    const int tid = tid_, w = F.wave, lane = tid & 63;
    const bf16* Qg = (const bf16*)(F.ws + WS_A1); const bf16* Kg = (const bf16*)(F.ws + WS_A2); bf16* Vg = (bf16*)(F.ws + WS_A3);
    LAS unsigned char* lds = F.lds;
    for (int unit = F.vcu2; unit < BATCH * RH * 8; unit += F.G) {
        const int s = unit & 7, bh = unit >> 3, h = bh % RH, b = bh / RH;
        const float gamma = 1.0f - exp2f(-(float)(5 + h));
        const float gC = expf(128.0f * logf(gamma));
        __syncthreads();
        for (int i = tid; i < ST2_BYTES / 4; i += NWAVES * 64) ((LAS unsigned*)(lds + ST_OFF))[i] = 0u;
        const size_t seq0 = (size_t)b * SEQ;
        unsigned long long* ssqh = REDIR ? (unsigned long long*)(F.ws + WS_A5 + 64 * MiB) : (unsigned long long*)(F.ws + WS_SSQH);
        bf16* Og = REDIR ? (bf16*)(F.ws + WS_A5) : (bf16*)F.out;     const size_t seq0o = REDIR ? (size_t)(b & 1) * SEQ : seq0;
        if (w == 0) scan3_owave<0, DRY>(lds, Qg, (const bf16*)F.out, Og, ssqh, seq0, h, s, lane, seq0o);
        else if (w == 1) scan3_owave<1, DRY>(lds, Qg, (const bf16*)F.out, Og, ssqh, seq0, h, s, lane, seq0o);
        else if (w == 2) scan3_owave<2, DRY>(lds, Qg, (const bf16*)F.out, Og, ssqh, seq0, h, s, lane, seq0o);
        else if (w == 3) scan3_owave<3, DRY>(lds, Qg, (const bf16*)F.out, Og, ssqh, seq0, h, s, lane, seq0o);
        else scan3_swave<DRY>(lds, (const char*)Kg + ((seq0 >> 7) * 16 + 4 * h) * (size_t)pg8::HTB, (const char*)Vg + ((seq0 >> 7) * 32 + 8 * h + s) * (size_t)pg8::HTB, gC, w & 3, tid & 255, lane);
    }
    __syncthreads();
}
__device__ __forceinline__ void conv_phase(Frame& F) {
    const int tid_ = opq(F.tid), lane_ = tid_ & 63;
    const bf16* Bc = (const bf16*)(F.ws + WS_A1); const bf16* Uc = (const bf16*)(F.ws + WS_A2); bf16* Z = (bf16*)(F.ws + WS_A4);
    const float* wcv = F.in[10];
    constexpr int RUN = 32;
    const int gw = F.vcu * NWAVES + F.wave, NGW = F.G * NWAVES;
    for (int it = gw; it < (T / RUN) * 2; it += NGW) {
        const int run = it >> 1, col = (it & 1) * 512 + lane_ * 8, t0 = run * RUN;
        float w0[8], w1[8], w2[8];
#pragma unroll
        for (int k = 0; k < 8; ++k) { w0[k] = wcv[col + k]; w1[k] = wcv[D + col + k]; w2[k] = wcv[2 * D + col + k]; }
        float um2[8], um1[8];
#pragma unroll
        for (int k = 0; k < 8; ++k) { um2[k] = 0.f; um1[k] = 0.f; }
        if ((t0 & (SEQ - 1)) != 0) {
            const v4u c2 = *(const GAS v4u*)(Uc + (size_t)(t0 - 2) * D + col), c1 = *(const GAS v4u*)(Uc + (size_t)(t0 - 1) * D + col);
            um2[0] = bflo(c2.x); um2[1] = bfhi(c2.x); um2[2] = bflo(c2.y); um2[3] = bfhi(c2.y); um2[4] = bflo(c2.z); um2[5] = bfhi(c2.z); um2[6] = bflo(c2.w); um2[7] = bfhi(c2.w);
            um1[0] = bflo(c1.x); um1[1] = bfhi(c1.x); um1[2] = bflo(c1.y); um1[3] = bfhi(c1.y); um1[4] = bflo(c1.z); um1[5] = bfhi(c1.z); um1[6] = bflo(c1.w); um1[7] = bfhi(c1.w);
        }
#pragma unroll 4
        for (int t = t0; t < t0 + RUN; ++t) {
            const size_t off = (size_t)t * D + col;
            const v4u cv = *(const GAS v4u*)(Uc + off), bv = *(const GAS v4u*)(Bc + off);
            float u[8], gb[8], z[8];
            u[0] = bflo(cv.x); u[1] = bfhi(cv.x); u[2] = bflo(cv.y); u[3] = bfhi(cv.y); u[4] = bflo(cv.z); u[5] = bfhi(cv.z); u[6] = bflo(cv.w); u[7] = bfhi(cv.w);
            gb[0] = bflo(bv.x); gb[1] = bfhi(bv.x); gb[2] = bflo(bv.y); gb[3] = bfhi(bv.y); gb[4] = bflo(bv.z); gb[5] = bfhi(bv.z); gb[6] = bflo(bv.w); gb[7] = bfhi(bv.w);
#pragma unroll
            for (int k = 0; k < 8; ++k) { z[k] = gb[k] * (w0[k] * um2[k] + w1[k] * um1[k] + w2[k] * u[k]); um2[k] = um1[k]; um1[k] = u[k]; }
            v4u wv; wv.x = pk2(z[0], z[1]); wv.y = pk2(z[2], z[3]); wv.z = pk2(z[4], z[5]); wv.w = pk2(z[6], z[7]);
            *(GAS v4u*)(Z + off) = wv;
        }
    }
}

__device__ __forceinline__ void router_row(const f32x4 (&v)[4], const f32x4 (&gg)[4], float rstd, const LAS float* Wr, int lane, float (&lg)[8]) {
#pragma unroll
    for (int e = 0; e < 8; ++e) lg[e] = 0.f;
#pragma unroll
    for (int j = 0; j < 4; ++j) { f32x4 y; y.x = v[j].x * rstd * gg[j].x; y.y = v[j].y * rstd * gg[j].y; y.z = v[j].z * rstd * gg[j].z; y.w = v[j].w * rstd * gg[j].w;
#pragma unroll
        for (int e = 0; e < 8; ++e) { const f32x4 wv = *(const LAS f32x4*)(Wr + e * D + 4 * lane + 256 * j);
            lg[e] += (y.x * wv.x + y.y * wv.y) + (y.z * wv.z + y.w * wv.w); } }
#pragma unroll
    for (int e = 0; e < 8; ++e) lg[e] = wave_sum(lg[e]);
}
__device__ __forceinline__ void router_pick(const float (&lg)[8], int& e0, int& e1, float& w0, float& w1) {
    e0 = 0; float l0 = lg[0];
#pragma unroll
    for (int e = 1; e < 8; ++e) if (lg[e] > l0) { l0 = lg[e]; e0 = e; }
    e1 = -1; float l1 = 0.f;
#pragma unroll
    for (int e = 0; e < 8; ++e) if (e != e0 && (e1 < 0 || lg[e] > l1)) { l1 = lg[e]; e1 = e; }
    const float ex = __expf(l1 - l0); w0 = 1.0f / (1.0f + ex); w1 = ex * w0;
}
__device__ __forceinline__ void router_phase(Frame& F) {
    const int tid_ = opq(F.tid), lane_ = tid_ & 63;
    LAS float* Wr = (LAS float*)F.lds;
    LAS unsigned* cnt = (LAS unsigned*)(F.lds + 32768);
    __syncthreads();
    for (int i = tid_; i < D * NE; i += NWAVES * 64) Wr[(i & 7) * D + (i >> 3)] = F.in[13][i];
    if (tid_ < NE) cnt[tid_] = 0u;
    __syncthreads();
    const bf16* Hs = (const bf16*)(F.ws + WS_A0); const float* gain = F.in[12];
    int* e01 = (int*)(F.ws + WS_E01); f32x2* w01 = (f32x2*)(F.ws + WS_W01); float* rstd3 = (float*)(F.ws + WS_RSTD3);
    const int gw = F.vcu * NWAVES + F.wave, NGW = F.G * NWAVES, lane = lane_;
    f32x4 gg[4];
#pragma unroll
    for (int j = 0; j < 4; ++j) gg[j] = ((const GAS f32x4*)gain + lane)[64 * j];
    for (int m = 2 * gw; m < T; m += 2 * NGW) {
        const GAS v2u* xa = (const GAS v2u*)(Hs + (size_t)m * D) + lane; const GAS v2u* xb = xa + D / 4;
        f32x4 va[4], vb[4]; float sa = 0.f, sb = 0.f;
#pragma unroll
        for (int j = 0; j < 4; ++j) { const v2u ra_ = xa[64 * j], rb_ = xb[64 * j];
            va[j] = (f32x4){bflo(ra_.x), bfhi(ra_.x), bflo(ra_.y), bfhi(ra_.y)}; vb[j] = (f32x4){bflo(rb_.x), bfhi(rb_.x), bflo(rb_.y), bfhi(rb_.y)}; }
#pragma unroll
        for (int j = 0; j < 4; ++j) { sa += (va[j].x * va[j].x + va[j].y * va[j].y) + (va[j].z * va[j].z + va[j].w * va[j].w); sb += (vb[j].x * vb[j].x + vb[j].y * vb[j].y) + (vb[j].z * vb[j].z + vb[j].w * vb[j].w); }
        const float ra = 1.0f / sqrtf(wave_sum(sa) * (1.f / D) + EPS), rb = 1.0f / sqrtf(wave_sum(sb) * (1.f / D) + EPS);
        { GAS unsigned* qa = (GAS unsigned*)(F.ws + WS_A8 + (size_t)m * D) + lane; GAS unsigned* qb = qa + D / 4;
#pragma unroll
          for (int j = 0; j < 4; ++j) { qa[64 * j] = pg8::pk4_fp8(va[j].x, va[j].y, va[j].z, va[j].w); qb[64 * j] = pg8::pk4_fp8(vb[j].x, vb[j].y, vb[j].z, vb[j].w); } }
        float la[8], lb[8];
        router_row(va, gg, ra, Wr, lane, la); router_row(vb, gg, rb, Wr, lane, lb);
        int a0, a1, b0, b1; float wa0, wa1, wb0, wb1;
        router_pick(la, a0, a1, wa0, wa1); router_pick(lb, b0, b1, wb0, wb1);
        if (lane == 0) { e01[m] = a0 | (a1 << 8); w01[m] = (f32x2){wa0, wa1}; rstd3[m] = ra; e01[m + 1] = b0 | (b1 << 8); w01[m + 1] = (f32x2){wb0, wb1}; rstd3[m + 1] = rb;
            atomicAdd((unsigned*)&cnt[a0], 1u); atomicAdd((unsigned*)&cnt[a1], 1u); atomicAdd((unsigned*)&cnt[b0], 1u); atomicAdd((unsigned*)&cnt[b1], 1u); }
    }
    __syncthreads();
    if (tid_ < NE) __hip_atomic_fetch_add(F.ctl + CW_MOE + 64 * tid_, cnt[tid_], __ATOMIC_RELAXED, __HIP_MEMORY_SCOPE_AGENT);
}
struct MoeOff { int o[9]; };
__device__ __forceinline__ void moe_offsets(Frame& F, int (&off)[9]) {
    off[0] = 0;
#pragma unroll
    for (int e = 0; e < 8; ++e) { const unsigned c = __hip_atomic_load(F.ctl + CW_MOE + 64 * e, __ATOMIC_RELAXED, __HIP_MEMORY_SCOPE_AGENT); off[e + 1] = off[e] + (int)((c + 255u) & ~255u); }
}
__device__ __forceinline__ void positions_phase(Frame& F) {
    const int tid_ = opq(F.tid), lane_ = tid_ & 63;
    int off[9]; moe_offsets(F, off);
    const int* e01 = (const int*)(F.ws + WS_E01); const f32x2* w01 = (const f32x2*)(F.ws + WS_W01);
    int* pos = (int*)(F.ws + WS_POS); int* idx = (int*)(F.ws + WS_IDX); float* gwt = (float*)(F.ws + WS_GW); float* prs = (float*)(F.ws + WS_PRS); const float* rstd3 = (const float*)(F.ws + WS_RSTD3);
    const int gw = F.vcu * NWAVES + F.wave, NGW = F.G * NWAVES, lane = lane_;
    const unsigned long long ltmask = (1ull << lane) - 1ull;
    for (int it = gw; it < T / 64; it += NGW) {
        const int t = it * 64 + lane; const int ee = e01[t]; const int e0 = ee & 0xff, e1 = ee >> 8; const f32x2 ww = w01[t];
        int p0 = 0, p1 = 0;
#pragma unroll
        for (int e = 0; e < 8; ++e) {
            const unsigned long long m0 = __ballot(e0 == e), m1 = __ballot(e1 == e);
            const int c0 = __popcll(m0), c1 = __popcll(m1);
            unsigned basev = 0u;
            if (lane == 0 && (c0 + c1) > 0) basev = __hip_atomic_fetch_add(F.ctl + CW_MOE + 64 * (8 + e), (unsigned)(c0 + c1), __ATOMIC_RELAXED, __HIP_MEMORY_SCOPE_AGENT);
            const int base = (int)__builtin_amdgcn_readfirstlane(basev) + off[e];
            if (e0 == e) p0 = base + __popcll(m0 & ltmask);
            if (e1 == e) p1 = base + c0 + __popcll(m1 & ltmask);
        }
        const float rs = rstd3[t];
        idx[p0] = t; gwt[p0] = ww.x; prs[p0] = rs; idx[p1] = t; gwt[p1] = ww.y; prs[p1] = rs;
        ((v2u*)pos)[t] = (v2u){(unsigned)p0, (unsigned)p1};
    }
    if (blockIdx.x < NE) {
        const int e = blockIdx.x; const int c = (int)__hip_atomic_load(F.ctl + CW_MOE + 64 * e, __ATOMIC_RELAXED, __HIP_MEMORY_SCOPE_AGENT);
        for (int p = off[e] + c + tid_; p < off[e + 1]; p += NWAVES * 64) { idx[p] = 0; gwt[p] = 0.f; prs[p] = 0.f; }
    }
}
__device__ __forceinline__ float f8tof(unsigned w, int i) { return i == 0 ? __builtin_amdgcn_cvt_f32_fp8((int)w, 0) : i == 1 ? __builtin_amdgcn_cvt_f32_fp8((int)w, 1) : i == 2 ? __builtin_amdgcn_cvt_f32_fp8((int)w, 2) : __builtin_amdgcn_cvt_f32_fp8((int)w, 3); }
__device__ __forceinline__ void final_phase(Frame& F) {
    const int tid_ = opq(F.tid), lane_ = tid_ & 63;
    const unsigned char* Yp = F.ws + WS_YP; const v2u* pos = (const v2u*)(F.ws + WS_POS); const f32x2* w01 = (const f32x2*)(F.ws + WS_W01); const float* gain = F.in[17];
    const int gw = F.vcu * NWAVES + F.wave, NGW = F.G * NWAVES, lane = lane_;
    f32x4 gg[4];
#pragma unroll
    for (int j = 0; j < 4; ++j) gg[j] = ((const GAS f32x4*)gain + lane)[64 * j];
    for (int m = 2 * gw; m < T; m += 2 * NGW) {
        f32x4 v[2][4]; unsigned ya[2][4], yb[2][4]; f32x2 ww[2];
#pragma unroll
        for (int q = 0; q < 2; ++q) { const v2u pp = pos[m + q]; ww[q] = w01[m + q];
            const GAS v2u* xr = (const GAS v2u*)((const bf16*)(F.ws + WS_A0) + (size_t)(m + q) * D) + lane;
            const GAS unsigned* y0 = (const GAS unsigned*)(Yp + (size_t)pp.x * D) + lane; const GAS unsigned* y1 = (const GAS unsigned*)(Yp + (size_t)pp.y * D) + lane;
#pragma unroll
            for (int j = 0; j < 4; ++j) { const v2u hx = xr[64 * j]; v[q][j] = (f32x4){bflo(hx.x), bfhi(hx.x), bflo(hx.y), bfhi(hx.y)}; ya[q][j] = y0[64 * j]; yb[q][j] = y1[64 * j]; } }
#pragma unroll
        for (int q = 0; q < 2; ++q) { float s = 0.f; const float wa = ww[q].x * (1.0f / Y8_SCALE), wb = ww[q].y * (1.0f / Y8_SCALE);
#pragma unroll
            for (int j = 0; j < 4; ++j) { const unsigned a = ya[q][j], b = yb[q][j];
                v[q][j].x += f8tof(a, 0) * wa + f8tof(b, 0) * wb; v[q][j].y += f8tof(a, 1) * wa + f8tof(b, 1) * wb; v[q][j].z += f8tof(a, 2) * wa + f8tof(b, 2) * wb; v[q][j].w += f8tof(a, 3) * wa + f8tof(b, 3) * wb;
                s += (v[q][j].x * v[q][j].x + v[q][j].y * v[q][j].y) + (v[q][j].z * v[q][j].z + v[q][j].w * v[q][j].w); }
            const float rstd = 1.0f / sqrtf(wave_sum(s) * (1.f / D) + EPS);
            GAS f32x4* xw = (GAS f32x4*)(F.out + (size_t)(m + q) * D) + lane;
#pragma unroll
            for (int j = 0; j < 4; ++j) { f32x4 y; y.x = v[q][j].x * rstd * gg[j].x; y.y = v[q][j].y * rstd * gg[j].y; y.z = v[q][j].z * rstd * gg[j].z; y.w = v[q][j].w * rstd * gg[j].w; xw[64 * j] = y; } }
    }
}

struct Args { const float* in[18]; float* out; unsigned char* ws; int ph_lo, ph_hi, li, pad; };
__global__ void __launch_bounds__(NWAVES * 64, 2) fwd_kernel(Args args) {
    extern __shared__ __attribute__((aligned(16))) unsigned char lds[];
    Frame F;
    F.lds = (LAS unsigned char*)lds;
    F.tid = threadIdx.x; F.lane = F.tid & 63; F.wave = __builtin_amdgcn_readfirstlane(F.tid >> 6);
    F.G = gridDim.x; { const int bx = blockIdx.x; F.vcu = (F.G % 8 == 0) ? (bx % 8) * (F.G / 8) + bx / 8 : bx; }
    unsigned char* ws = args.ws; F.ws = ws; F.out = args.out;
    F.ctl = (unsigned*)(ws + WS_CTL);
#pragma unroll
    for (int i = 0; i < 18; ++i) F.in[i] = args.in[i];
    volatile LAS unsigned* MISC = (volatile LAS unsigned*)(F.lds + MISC_OFF);
    for (int u = F.tid; u < (LDS_BYTES - RING_BYTES) / 4; u += NWAVES * 64) ((LAS unsigned*)(F.lds + RING_BYTES))[u] = 0u;
    __syncthreads();
    XcdBarrier bar = xcd_barrier_post(F.ctl + CW_BAR + args.li * XCD_BAR_WORDS, MISC + 8);
    LAS unsigned char* ring = F.lds;
#define GRID_BAR() xcd_barrier(bar)
    unsigned long long* ssq1 = (unsigned long long*)(ws + WS_SSQ1); unsigned long long* ssq2 = (unsigned long long*)(ws + WS_SSQ2);
    p0_prologue(F);
#if defined(PROBE_P0) || defined(PROBE_PASSES)
    GRID_BAR(); p0_prologue(F);
#endif
    GRID_BAR();
    {
        unsigned* barw = F.ctl + CW_BAR + args.li * XCD_BAR_WORDS; unsigned pre = 0u;
#pragma unroll
        for (unsigned j = 0; j < 16; ++j) { const unsigned c = xb_ld(&barw[XB_XCNT(j)]); pre += (j < bar.x) ? c : 0u; }
        F.vcu2 = __builtin_amdgcn_readfirstlane((int)(pre + MISC[10])); }
    {   pg8::Gemm g{(const bf16*)(ws + WS_A0), (const bf16*)(ws + WS_WRIN), 1024, nullptr, nullptr}; pg8::StaticOrder S; S.init(T / 256, 24, F.G, (int)blockIdx.x);
        pg8::EpiRetIn E{(bf16*)(ws + WS_A1), (bf16*)(ws + WS_A2), (bf16*)(ws + WS_A3), (bf16*)F.out, (const float*)(ws + WS_ROPE)};
        pg8::gemm_phase(ring, g, S, E); }
    GRID_BAR();
#ifdef PROBE_SCAN
    ret_scan_phase3<false, true>(F); GRID_BAR(); ret_scan_phase3<false, true>(F); GRID_BAR(); ret_scan_phase3<false, true>(F); GRID_BAR();
#endif
    ret_scan_phase3<false>(F);
    GRID_BAR();
    {   pg8::Gemm g{(const bf16*)F.out, (const bf16*)(ws + WS_WROUT), 2048, nullptr, (const unsigned long long*)(ws + WS_SSQH), true};     pg8::StaticOrder S; S.init(T / 256, 4, F.G, (int)blockIdx.x);
        pg8::EpiResNorm<false, false> E{F.in[0], nullptr, nullptr, (bf16*)(ws + WS_A0), ssq1, D, 1.0f};
        pg8::gemm_phase<pg8::EpiResNorm<false, false>, pg8::StaticOrder, false, true>(ring, g, S, E); }
    GRID_BAR();
    {   pg8::Gemm g{(const bf16*)(ws + WS_A0), (const bf16*)(ws + WS_WFGU), 1024, nullptr, nullptr}; pg8::StaticOrder S; S.init(T / 256, 28, F.G, (int)blockIdx.x);
        pg8::EpiSwiglu E{(bf16*)(ws + WS_A1), FF, ssq1, nullptr, -1, {{0.f, 0.f, 0.f, 0.f}, {0.f, 0.f, 0.f, 0.f}}, FFN8 ? ws + WS_A1 : nullptr, H8_SCALE};
        pg8::gemm_phase(ring, g, S, E);
#if defined(PROBE_P7X2) || defined(PROBE_G3)
        GRID_BAR(); pg8::gemm_phase(ring, g, S, E);
#endif
    }
    GRID_BAR();
    {   pg8::Gemm g{(const bf16*)(ws + WS_A1), (const bf16*)(ws + WS_WFD), FF, nullptr, nullptr, FFN8}; pg8::StaticOrder S; S.init(T / 256, 4, F.G, (int)blockIdx.x);
        pg8::EpiResNorm<true, false> E{nullptr, (const bf16*)(ws + WS_A0), nullptr, (bf16*)(ws + WS_A0), ssq2, D, FFN8 ? 1.0f / (W8_SCALE * H8_SCALE) : 1.0f};
        if constexpr (FFN8) pg8::gemm_phase<pg8::EpiResNorm<true, false>, pg8::StaticOrder, true>(ring, g, S, E); else pg8::gemm_phase(ring, g, S, E); }
    GRID_BAR();
    {   pg8::Gemm g{(const bf16*)(ws + WS_A0), (const bf16*)(ws + WS_WCIN), 1024, nullptr, nullptr}; pg8::StaticOrder S; S.init(T / 256, 12, F.G, (int)blockIdx.x);
        pg8::EpiConvIn E{(bf16*)(ws + WS_A1), (bf16*)(ws + WS_A2), ssq2, -1, {{0.f, 0.f, 0.f, 0.f}, {0.f, 0.f, 0.f, 0.f}}};
        pg8::gemm_phase(ring, g, S, E);
#ifdef PROBE_G3
        GRID_BAR(); pg8::gemm_phase(ring, g, S, E);
#endif
    }
    GRID_BAR();
    conv_phase(F);
#ifdef PROBE_PASSES
    GRID_BAR(); conv_phase(F);
#endif
    GRID_BAR();
    {   pg8::Gemm g{(const bf16*)(ws + WS_A4), (const bf16*)(ws + WS_WCOUT), 1024, nullptr, nullptr}; pg8::StaticOrder S; S.init(T / 256, 4, F.G, (int)blockIdx.x);
        pg8::EpiResNorm<true, false> E{nullptr, (const bf16*)(ws + WS_A0), nullptr, (bf16*)(ws + WS_A0), nullptr, D, 1.0f};
        pg8::gemm_phase(ring, g, S, E); }
    GRID_BAR();
    router_phase(F);
    GRID_BAR();
    positions_phase(F);
    GRID_BAR();
#ifdef PROBE_MOEX2
    for (int rep = 0; rep < 2; ++rep)
#endif
    {   int off[9]; moe_offsets(F, off);
        const int NT = off[8] >> 8;
#pragma unroll 1
        for (int sl = 0; sl < 1; ++sl) {
            const int t0 = 0, nm = NT;
            if (nm > 0 && nm <= HM_TILES) {
                { pg8::Gemm g{(const bf16*)(ws + WS_A8), (const bf16*)(ws + WS_WMGU), 1024, (const int*)(ws + WS_IDX), nullptr};
                  pg8::MoeOrder S; S.base.init(nm, 28, F.G, (int)blockIdx.x); S.t0 = t0; S.ntile_e = 28; S.a_local = false;
                  S.o1 = off[1] >> 8; S.o2 = off[2] >> 8; S.o3 = off[3] >> 8; S.o4 = off[4] >> 8; S.o5 = off[5] >> 8; S.o6 = off[6] >> 8; S.o7 = off[7] >> 8;
                  pg8::EpiSwiglu8 E{ws + WS_HM, FF, (const float*)(ws + WS_PRS), 1.0f / W8_SCALE, H8_SCALE, -1, {{0.f, 0.f, 0.f, 0.f}, {0.f, 0.f, 0.f, 0.f}}};
                  pg8::gemm_phase<pg8::EpiSwiglu8, pg8::MoeOrder, true>(ring, g, S, E); }
                GRID_BAR();
                { pg8::Gemm g{(const bf16*)(ws + WS_HM), (const bf16*)(ws + WS_WMD), FF, nullptr, nullptr, true};
                  pg8::MoeOrder S; S.base.init(nm, 4, F.G, (int)blockIdx.x); S.t0 = t0; S.ntile_e = 4; S.a_local = true;
                  S.o1 = off[1] >> 8; S.o2 = off[2] >> 8; S.o3 = off[3] >> 8; S.o4 = off[4] >> 8; S.o5 = off[5] >> 8; S.o6 = off[6] >> 8; S.o7 = off[7] >> 8;
                  pg8::EpiScaleF8 E{ws + WS_YP, D, Y8_SCALE / (W8_SCALE * H8_SCALE)};
                  pg8::gemm_phase<pg8::EpiScaleF8, pg8::MoeOrder, true>(ring, g, S, E); }
                GRID_BAR();
            }
        }
    }
#ifdef PROBE_BARS
    for (int rep = 0; rep < 10; ++rep) GRID_BAR();
#endif
    final_phase(F);
#ifdef PROBE_PASSES
    GRID_BAR(); final_phase(F);
#endif
}

extern "C" void kernel_launch(void* const* d_in, const int* in_sizes, int n_in, void* d_out, int out_size, void* d_ws, size_t ws_size, hipStream_t stream) {
    static int grid = 0;
    if (grid == 0) {
        if (n_in != 18 || in_sizes[0] != T * D || out_size != T * D || ws_size < WS_END) { fprintf(stderr, "kernel_launch: unexpected shapes (n_in %d, ws %zu)\n", n_in, ws_size); grid = -1; return; }
        int dev = 0, cus = 0, per_cu = 0;
        if (hipGetDevice(&dev) != hipSuccess || hipDeviceGetAttribute(&cus, hipDeviceAttributeMultiprocessorCount, dev) != hipSuccess) { grid = -1; return; }
        if (hipFuncSetAttribute((const void*)fwd_kernel, hipFuncAttributeMaxDynamicSharedMemorySize, LDS_BYTES) != hipSuccess) { grid = -1; return; }
        if (hipOccupancyMaxActiveBlocksPerMultiprocessor(&per_cu, (const void*)fwd_kernel, NWAVES * 64, LDS_BYTES) != hipSuccess || per_cu < 1) { fprintf(stderr, "kernel_launch: occupancy query says %d\n", per_cu); }
        (void)hipGetLastError();
        grid = cus;
    }
    if (grid < 0) return;
    if (hipMemsetAsync((char*)d_ws + WS_CTL, 0, CTL_ZERO_BYTES, stream) != hipSuccess) return;
    Args a{};
    for (int i = 0; i < 18; ++i) a.in[i] = (const float*)d_in[i];
    a.out = (float*)d_out; a.ws = (unsigned char*)d_ws; a.pad = 0;
    a.ph_lo = 0; a.ph_hi = NPH; a.li = 0;
    hipLaunchKernelGGL(fwd_kernel, dim3(grid), dim3(NWAVES * 64), LDS_BYTES, stream, a);
}
```
